# Optimizing an MI355X kernel written in HIP

```python
import jax, jax.numpy as jnp
from jax import lax
import numpy as np

D_MODEL = 1024
BATCH = 8
SEQ = 2048
DEPTH = 1

D_MIX = D_MODEL
HEAD_DIM = 64
N_HEADS = 8
N_KV_HEADS = 2
GQA_GROUP = N_HEADS // N_KV_HEADS
D_ATTN = N_HEADS * HEAD_DIM
D_KV = N_KV_HEADS * HEAD_DIM
D_POOL = D_MIX - D_ATTN
POOL_WINDOWS = (2, 4, 8, 16)
N_POOL_GROUPS = len(POOL_WINDOWS)
POOL_GROUP_DIM = D_POOL // N_POOL_GROUPS
D_IN = D_ATTN + 2 * D_KV + D_POOL
WINDOW = 128
BLOCK = 128
N_BUCKETS = 32
MAX_DISTANCE = 128
D_FF = 2816
EPS = 1e-6
NEG = -1e30

kernel_name = "hybrid_swa_sink_pool_macaron"


def _rmsnorm(x, g):
    x32 = x.astype(jnp.float32)
    y = x32 * lax.rsqrt(jnp.mean(x32 * x32, axis=-1, keepdims=True) + EPS)
    return (y * g.astype(jnp.float32)).astype(x.dtype)


def _swiglu(h, w_gate, w_up, w_down):
    return (jax.nn.silu(h @ w_gate) * (h @ w_up)) @ w_down


def _t5_bucket(dist):
    n = np.maximum(dist, 0)
    max_exact = N_BUCKETS // 2
    large = max_exact + (np.log(np.maximum(n, 1) / max_exact)
                         / np.log(MAX_DISTANCE / max_exact)
                         * (N_BUCKETS - max_exact)).astype(np.int32)
    large = np.minimum(large, N_BUCKETS - 1)
    return np.where(n < max_exact, n, large).astype(np.int32)


def _band_structure(n_blocks):
    ql = np.arange(BLOCK)[:, None]
    kl = np.arange(2 * BLOCK)[None, :]
    dist = ql + BLOCK - kl
    bucket = _t5_bucket(dist)
    blk = np.arange(n_blocks)[:, None, None]
    k_abs = blk * BLOCK - BLOCK + kl[None]
    mask = (dist[None] >= 0) & (dist[None] < WINDOW) & (k_abs >= 0)
    return bucket, mask


def _sliding_window_attention(q, k, v, q_gain, k_gain, sinks, rel_bias):
    B, S = q.shape[0], q.shape[1]
    nb = S // BLOCK
    q = _rmsnorm(q, q_gain)
    k = _rmsnorm(k, k_gain)
    bucket, mask = _band_structure(nb)
    bias = jnp.transpose(rel_bias[jnp.asarray(bucket)], (2, 0, 1)).astype(jnp.float32)
    bias = bias.reshape(N_KV_HEADS, GQA_GROUP, BLOCK, 2 * BLOCK)
    mask = jnp.asarray(mask)[None, :, None, None]

    qb = q.reshape(B, nb, BLOCK, N_KV_HEADS, GQA_GROUP, HEAD_DIM)
    pad = ((0, 0), (BLOCK, 0), (0, 0), (0, 0))
    kp = jnp.pad(k, pad).reshape(B, nb + 1, BLOCK, N_KV_HEADS, HEAD_DIM)
    vp = jnp.pad(v, pad).reshape(B, nb + 1, BLOCK, N_KV_HEADS, HEAD_DIM)
    kb = jnp.concatenate([kp[:, :-1], kp[:, 1:]], axis=2)
    vb = jnp.concatenate([vp[:, :-1], vp[:, 1:]], axis=2)

    logits = jnp.einsum('bnqkgd,bnskd->bnkgqs', qb, kb).astype(jnp.float32)
    logits = logits * (HEAD_DIM ** -0.5) + bias[None, None]
    logits = jnp.where(mask, logits, NEG)
    sink = sinks.astype(jnp.float32).reshape(N_KV_HEADS, GQA_GROUP)[None, None, :, :, None, None]
    m = jnp.maximum(jnp.max(logits, axis=-1, keepdims=True), sink)
    e = jnp.exp(logits - m)
    probs = e / (jnp.sum(e, axis=-1, keepdims=True) + jnp.exp(sink - m))
    out = jnp.einsum('bnkgqs,bnskd->bnqkgd', probs.astype(vb.dtype), vb)
    return out.reshape(B, S, D_ATTN)


def _pool_mixer(u, w_pool, scale):
    B, S = u.shape[0], u.shape[1]
    ug = u.reshape(B, S, N_POOL_GROUPS, POOL_GROUP_DIM)
    csum = jnp.cumsum(ug.astype(jnp.float32), axis=1)
    pos = jnp.arange(1, S + 1, dtype=jnp.float32)
    means = []
    for g, w in enumerate(POOL_WINDOWS):
        cg = csum[:, :, g]
        prev = jnp.pad(cg, ((0, 0), (w, 0), (0, 0)))[:, :S]
        cnt = jnp.minimum(pos, float(w))[None, :, None]
        means.append((cg - prev) / cnt)
    pooled = jnp.stack(means, axis=2).astype(u.dtype) - ug
    y = jnp.einsum('bsgc,gcd->bsgd', pooled, w_pool).reshape(B, S, D_POOL)
    return y * scale


def setup_inputs(seed: int = 0) -> dict:
    key = jax.random.key(seed)
    ks = jax.random.split(key, 20)
    nrm = lambda k, shape, fan_in: jax.random.normal(k, shape, jnp.float32) * fan_in ** -0.5
    gain = lambda k, shape: 1.0 + 0.02 * jax.random.normal(k, shape, jnp.float32)
    L = DEPTH
    return {
        "x": jax.random.normal(ks[0], (BATCH, SEQ, D_MODEL), jnp.float32),
        "ffn1_norm": gain(ks[1], (L, D_MODEL)),
        "ffn1_w_gate": nrm(ks[2], (L, D_MODEL, D_FF), D_MODEL),
        "ffn1_w_up": nrm(ks[3], (L, D_MODEL, D_FF), D_MODEL),
        "ffn1_w_down": nrm(ks[4], (L, D_FF, D_MODEL), D_FF),
        "mix_norm": gain(ks[5], (L, D_MODEL)),
        "w_in": nrm(ks[6], (L, D_MODEL, D_IN), D_MODEL),
        "q_norm": gain(ks[7], (L, HEAD_DIM)),
        "k_norm": gain(ks[8], (L, HEAD_DIM)),
        "attn_sinks": 0.5 * jax.random.normal(ks[9], (L, N_HEADS), jnp.float32),
        "rel_bias": 0.1 * jax.random.normal(ks[10], (N_BUCKETS, N_HEADS), jnp.float32),
        "pool_w": nrm(ks[11], (L, N_POOL_GROUPS, POOL_GROUP_DIM, POOL_GROUP_DIM), POOL_GROUP_DIM),
        "pool_scale": gain(ks[12], (L, D_POOL)),
        "w_out": nrm(ks[13], (L, D_MIX, D_MODEL), D_MIX),
        "ffn2_norm": gain(ks[14], (L, D_MODEL)),
        "ffn2_w_gate": nrm(ks[15], (L, D_MODEL, D_FF), D_MODEL),
        "ffn2_w_up": nrm(ks[16], (L, D_MODEL, D_FF), D_MODEL),
        "ffn2_w_down": nrm(ks[17], (L, D_FF, D_MODEL), D_FF),
    }


def reference(x, ffn1_norm, ffn1_w_gate, ffn1_w_up, ffn1_w_down, mix_norm, w_in,
              q_norm, k_norm, attn_sinks, rel_bias, pool_w, pool_scale, w_out,
              ffn2_norm, ffn2_w_gate, ffn2_w_up, ffn2_w_down):
    B, S = x.shape[0], x.shape[1]
    for l in range(DEPTH):
        h = _rmsnorm(x, ffn1_norm[l])
        x = x + 0.5 * _swiglu(h, ffn1_w_gate[l], ffn1_w_up[l], ffn1_w_down[l])
        h = _rmsnorm(x, mix_norm[l])
        z = h @ w_in[l]
        q = z[..., :D_ATTN].reshape(B, S, N_HEADS, HEAD_DIM)
        k = z[..., D_ATTN:D_ATTN + D_KV].reshape(B, S, N_KV_HEADS, HEAD_DIM)
        v = z[..., D_ATTN + D_KV:D_ATTN + 2 * D_KV].reshape(B, S, N_KV_HEADS, HEAD_DIM)
        u = z[..., D_ATTN + 2 * D_KV:]
        y_attn = _sliding_window_attention(q, k, v, q_norm[l], k_norm[l],
                                           attn_sinks[l], rel_bias)
        y_pool = _pool_mixer(u, pool_w[l], pool_scale[l])
        x = x + jnp.concatenate([y_attn, y_pool], axis=-1) @ w_out[l]
        h = _rmsnorm(x, ffn2_norm[l])
        x = x + 0.5 * _swiglu(h, ffn2_w_gate[l], ffn2_w_up[l], ffn2_w_down[l])
    return x
```

```cpp
#include <hip/hip_runtime.h>
#include <cstdio>
#include <cstdint>

#ifndef MK_N_LAUNCHES
#define MK_N_LAUNCHES 1
#endif
#ifndef PROBE_REP
#define PROBE_REP -1
#endif
#ifndef PROBE_XBAR
#define PROBE_XBAR 0
#endif
#define NREP(k) ((k) == PROBE_REP ? 2 : 1)
#define rep_first(k) true

namespace pg8 {
#define PG8_LAS __attribute__((address_space(3)))
typedef unsigned short bf16_t;
typedef short bf16x8 __attribute__((ext_vector_type(8)));
typedef float f32x4 __attribute__((ext_vector_type(4)));
typedef unsigned u32x4 __attribute__((ext_vector_type(4)));
typedef unsigned u32x2 __attribute__((ext_vector_type(2)));
constexpr int BM = 256, BK = 64, HALF = 128, HTB = HALF * BK * 2, STAGE_BYTES = 8 * HTB, NXCD = 8, WGM = 8;

__host__ __device__ __forceinline__ int lds_byte(int r, int c) { const int st = (r >> 4) * 2 + (c >> 5), rr = r & 15, cc = c & 31, ob = rr * 64 + cc * 2; return st * 1024 + (ob ^ (((ob >> 9) & 1) << 5)); }
__host__ __device__ __forceinline__ void stage_rc(int b, int& R, int& C) { const int st = b / 1024, sb = b % 1024, swz = sb ^ (((sb >> 9) & 1) << 5); R = (st >> 1) * 16 + swz / 64; C = (st & 1) * 32 + (swz % 64) / 2; }
__host__ __device__ __forceinline__ int perm32(int rho) { const int n = rho >> 4, i = rho & 15; return 8 * (i >> 2) + 4 * n + (i & 3); }

struct Unit { int pm, pn; };
struct Gemm { const bf16_t* A; const bf16_t* Bt; int M, N, K; int lda = 0; };

struct StaticOrder {
    int nM, nN, nwg, G, c, r0 = 0, r1 = 1 << 20;
    __host__ __device__ void init(int M, int N, int G_, int c_) { nM = M / BM; nN = N / BM; nwg = nM * nN; G = G_; c = c_; }
    __host__ __device__ bool next(int i, Unit& u) const {
        if (r0 + i >= r1) return false;
        const long L = (long)(r0 + i) * G + c; if (L >= nwg) return false;
        int wgid = (int)L; { const int q = nwg / NXCD, r = nwg % NXCD, xcd = wgid % NXCD, off = wgid / NXCD; wgid = (xcd < r ? xcd * (q + 1) : r * (q + 1) + (xcd - r) * q) + off; }
        const int nig = WGM * nN, gid = wgid / nig, fm = gid * WGM, gsz = (nM - fm) < WGM ? (nM - fm) : WGM;
        u.pm = fm + ((wgid % nig) % gsz); u.pn = (wgid % nig) / gsz; return true;
    }
    __device__ __forceinline__ void a_ready(const Unit&) const {}
    __device__ __forceinline__ void done(const Unit&) const {}
};

#define WT_RSRC(p) __builtin_amdgcn_make_buffer_rsrc((void*)(p), 0, 0x7ffffff0, 0x00020000)
#define WT_ST16(rs, byteoff, v) __builtin_amdgcn_raw_buffer_store_b128((v), (rs), (int)(byteoff), 0, 16)
__device__ __forceinline__ unsigned cvt_pk_bf16(float lo, float hi) { unsigned r; asm volatile("v_cvt_pk_bf16_f32 %0, %1, %2" : "=v"(r) : "v"(lo), "v"(hi)); return r; }

struct RstdPre { f32x4 t[2]; };
struct NoPre {};
__device__ __forceinline__ void rstd_prefetch(RstdPre& p, const float* ss, int rowbase, int lane) {
    p.t[0] = *(const f32x4*)(ss + (size_t)(rowbase + lane) * 4); p.t[1] = *(const f32x4*)(ss + (size_t)(rowbase + 128 + lane) * 4);
}
__device__ __forceinline__ void rstd_finish(const RstdPre& p, int fr, float (&rs)[2][4]) {
    float v[2];
#pragma unroll
    for (int ai = 0; ai < 2; ++ai) { const f32x4 a = p.t[ai]; v[ai] = __builtin_amdgcn_rsqf(((a[0] + a[1]) + (a[2] + a[3])) * (1.0f / 1024.0f) + 1e-6f); }
#pragma unroll
    for (int ai = 0; ai < 2; ++ai)
#pragma unroll
        for (int m = 0; m < 4; ++m) rs[ai][m] = __shfl(v[ai], 16 * m + fr);
}

struct EpiSwiGLU {
    static constexpr bool PERM = true, AFTER_DRAIN = false;
    typedef RstdPre Pre;
    bf16_t* H; int ldh; const float* ss;
    __device__ __forceinline__ void prefetch(Pre& p, const Unit& u, int wr, int lane) const { rstd_prefetch(p, ss, u.pm * BM + wr * 64, lane); }
    __device__ __forceinline__ void operator()(const f32x4 (&acc)[2][2][4][2], const Pre& p, const Unit& u, int wr, int wc, int fr, int fq) const {
        const int row0 = u.pm * BM + wr * 64 + fr, col0 = u.pn * HALF + wc * 32 + 8 * fq;
        float rsv[2][4]; rstd_finish(p, fr, rsv);
#pragma unroll
        for (int ai = 0; ai < 2; ++ai)
#pragma unroll
            for (int m = 0; m < 4; ++m) {
                const int row = row0 + ai * HALF + m * 16; const float rs = rsv[ai][m], c1 = rs * -1.4426950408889634f, rs2 = rs * rs;
                f32x4 h[2];
#pragma unroll
                for (int n = 0; n < 2; ++n) {
                    const f32x4 g = acc[ai][0][m][n], uu = acc[ai][1][m][n];
                    const f32x4 t = g * c1;
                    f32x4 e; e[0] = __builtin_amdgcn_exp2f(t[0]); e[1] = __builtin_amdgcn_exp2f(t[1]); e[2] = __builtin_amdgcn_exp2f(t[2]); e[3] = __builtin_amdgcn_exp2f(t[3]);
                    const f32x4 d = e + 1.0f;
                    f32x4 r; r[0] = __builtin_amdgcn_rcpf(d[0]); r[1] = __builtin_amdgcn_rcpf(d[1]); r[2] = __builtin_amdgcn_rcpf(d[2]); r[3] = __builtin_amdgcn_rcpf(d[3]);
                    h[n] = ((g * uu) * rs2) * r;
                }
                u32x4 w;
                w.x = cvt_pk_bf16(h[0][0], h[0][1]); w.y = cvt_pk_bf16(h[0][2], h[0][3]); w.z = cvt_pk_bf16(h[1][0], h[1][1]); w.w = cvt_pk_bf16(h[1][2], h[1][3]);
                *(u32x4*)(H + (size_t)row * ldh + col0) = w;
            }
    }
};
struct EpiZ {
    static constexpr bool PERM = true, AFTER_DRAIN = false;
    typedef RstdPre Pre;
    bf16_t* Z; int ldz; const float* ss; const float* qg; const float* kg; float qscale;
    __device__ __forceinline__ void prefetch(Pre& p, const Unit& u, int wr, int lane) const { rstd_prefetch(p, ss, u.pm * BM + wr * 64, lane); }
    __device__ __forceinline__ void operator()(const f32x4 (&acc)[2][2][4][2], const Pre& p, const Unit& u, int wr, int wc, int fr, int fq) const {
        const int row0 = u.pm * BM + wr * 64 + fr, slot = u.pn * 4 + wc, col0 = slot * 64 + 8 * fq;
        const int kind = slot < 8 ? 0 : (slot < 10 ? 1 : 2);
        f32x4 gv[2][2];
#pragma unroll
        for (int bj = 0; bj < 2; ++bj)
#pragma unroll
            for (int n = 0; n < 2; ++n) {
                if (kind < 2) { const f32x4 t = *(const f32x4*)((kind == 0 ? qg : kg) + 32 * bj + 8 * fq + 4 * n); gv[bj][n] = kind == 0 ? t * qscale : t; }
                else gv[bj][n] = (f32x4){1.f, 1.f, 1.f, 1.f};
            }
        float rsv[2][4]; rstd_finish(p, fr, rsv);
#pragma unroll
        for (int ai = 0; ai < 2; ++ai)
#pragma unroll
            for (int m = 0; m < 4; ++m) {
                const int row = row0 + ai * HALF + m * 16; const float rs = rsv[ai][m];
                f32x4 v[2][2]; float q = 0.f;
#pragma unroll
                for (int bj = 0; bj < 2; ++bj)
#pragma unroll
                    for (int n = 0; n < 2; ++n) { v[bj][n] = acc[ai][bj][m][n] * rs; const f32x4 t = v[bj][n]; q += (t[0] * t[0] + t[1] * t[1]) + (t[2] * t[2] + t[3] * t[3]); }
                if (kind < 2) {
                    q += __shfl_xor(q, 16); q += __shfl_xor(q, 32);
                    const float rn = __builtin_amdgcn_rsqf(q * (1.0f / 64.0f) + 1e-6f);
#pragma unroll
                    for (int bj = 0; bj < 2; ++bj)
#pragma unroll
                        for (int n = 0; n < 2; ++n) v[bj][n] = v[bj][n] * rn * gv[bj][n];
                }
#pragma unroll
                for (int bj = 0; bj < 2; ++bj) {
                    u32x4 w; w.x = cvt_pk_bf16(v[bj][0][0], v[bj][0][1]); w.y = cvt_pk_bf16(v[bj][0][2], v[bj][0][3]); w.z = cvt_pk_bf16(v[bj][1][0], v[bj][1][1]); w.w = cvt_pk_bf16(v[bj][1][2], v[bj][1][3]);
                    *(u32x4*)(Z + (size_t)row * ldz + col0 + 32 * bj) = w;
                }
            }
    }
};
template <bool RBF, bool OBF> struct EpiResid {
    static constexpr bool PERM = true, AFTER_DRAIN = OBF;
    typedef NoPre Pre;
    const float* R; const bf16_t* Rb; float* out; bf16_t* xb; float* ss; float alpha;
    __device__ __forceinline__ void prefetch(Pre&, const Unit&, int, int) const {}
    __device__ __forceinline__ void operator()(const f32x4 (&acc)[2][2][4][2], const Pre&, const Unit& u, int wr, int wc, int fr, int fq) const { body(acc, u, wr, wc, fr, fq, nullptr); }
    __device__ __forceinline__ void fused(const f32x4 (&acc)[2][2][4][2], const Unit& u, int wr, int wc, int fr, int fq, PG8_LAS unsigned char* lds, int wid, int lane) const {
        body(acc, u, wr, wc, fr, fq, (PG8_LAS float*)lds);
        asm volatile("s_waitcnt lgkmcnt(0)" ::: "memory"); __builtin_amdgcn_s_barrier(); asm volatile("" ::: "memory");
        const int t = wid * 64 + lane;
        if (t < 256) { const f32x4 p = ((const PG8_LAS f32x4*)lds)[t]; ss[(size_t)(u.pm * BM + t) * 4 + u.pn] = (p[0] + p[1]) + (p[2] + p[3]); }
    }
    __device__ __forceinline__ void body(const f32x4 (&acc)[2][2][4][2], const Unit& u, int wr, int wc, int fr, int fq, PG8_LAS float* P) const {
        const int row0 = u.pm * BM + wr * 64 + fr, col0 = u.pn * BM + wc * 32 + 8 * fq;
        f32x4 rf[3][2][2]; u32x4 rh[3][2];
#define PG8_RLOAD(i) do { const size_t off_ = (size_t)(row0 + ((i) >> 2) * HALF + ((i) & 3) * 16) * 1024 + col0; _Pragma("unroll") for (int bj = 0; bj < 2; ++bj) { \
            if (RBF) rh[(i) % 3][bj] = *(const u32x4*)(Rb + off_ + bj * HALF); \
            else { rf[(i) % 3][bj][0] = *(const f32x4*)(R + off_ + bj * HALF); rf[(i) % 3][bj][1] = *(const f32x4*)(R + off_ + bj * HALF + 4); } } } while (0)
        PG8_RLOAD(0); PG8_RLOAD(1);
#pragma unroll
        for (int i = 0; i < 8; ++i) {
            const int ai = i >> 2, m = i & 3;
            if (i + 2 < 8) PG8_RLOAD(i + 2);
            asm volatile("" ::: "memory");
            const int row = row0 + ai * HALF + m * 16; const size_t off = (size_t)row * 1024 + col0; float q = 0.f;
#pragma unroll
            for (int bj = 0; bj < 2; ++bj) {
                f32x4 r0, r1;
                if (RBF) { const u32x4 h = rh[i % 3][bj];
                    r0 = (f32x4){__builtin_bit_cast(float, h.x << 16), __builtin_bit_cast(float, h.x & 0xffff0000u), __builtin_bit_cast(float, h.y << 16), __builtin_bit_cast(float, h.y & 0xffff0000u)};
                    r1 = (f32x4){__builtin_bit_cast(float, h.z << 16), __builtin_bit_cast(float, h.z & 0xffff0000u), __builtin_bit_cast(float, h.w << 16), __builtin_bit_cast(float, h.w & 0xffff0000u)}; }
                else { r0 = rf[i % 3][bj][0]; r1 = rf[i % 3][bj][1]; }
                const f32x4 o0 = r0 + acc[ai][bj][m][0] * alpha, o1 = r1 + acc[ai][bj][m][1] * alpha;
                if (OBF) {
                    u32x4 w; w.x = cvt_pk_bf16(o0[0], o0[1]); w.y = cvt_pk_bf16(o0[2], o0[3]); w.z = cvt_pk_bf16(o1[0], o1[1]); w.w = cvt_pk_bf16(o1[2], o1[3]);
                    *(u32x4*)(xb + off + bj * HALF) = w;
#pragma unroll
                    for (int e = 0; e < 4; ++e) { const float lo = __builtin_bit_cast(float, w[e] << 16), hi = __builtin_bit_cast(float, w[e] & 0xffff0000u); q += lo * lo + hi * hi; }
                } else { __builtin_nontemporal_store(o0, (f32x4*)(out + off + bj * HALF)); __builtin_nontemporal_store(o1, (f32x4*)(out + off + bj * HALF + 4)); }
            }
            if (OBF) { q += __shfl_xor(q, 16); q += __shfl_xor(q, 32); if (fq == 0) P[(ai * HALF + wr * 64 + m * 16 + fr) * 4 + wc] = q; }
            asm volatile("" ::: "memory");
        }
#undef PG8_RLOAD
    }
};

template <class Epi, class Sched, bool ALIGN_EPI = false, bool SP2 = false>
__device__ __forceinline__ void gemm_phase(PG8_LAS unsigned char* lds, const Gemm g, const Sched& S, const Epi& E) {
    const int tid = threadIdx.x, wid = __builtin_amdgcn_readfirstlane(tid >> 6), lane = tid & 63, wr = wid >> 2, wc = wid & 3, fr = lane & 15, fq = lane >> 4;
    const int K = g.K, nt = K / BK, lda = g.lda ? g.lda : g.K;
    unsigned voffA[2], voffB[2];
#pragma unroll
    for (int i = 0; i < 2; ++i) { int R, C; stage_rc(tid * 16 + i * 8192, R, C); const int Rb = Epi::PERM ? ((R & ~31) + perm32(R & 31)) : R;
        voffA[i] = (unsigned)(R * lda + C) * 2u; voffB[i] = (unsigned)(Rb * K + C) * 2u; }
    const size_t kstep = (size_t)(BK * 2);
    const size_t hstep = (size_t)HALF * K * 2, hstepA = (size_t)HALF * lda * 2;
    const size_t tstep = 2 * hstep, tstepA = 2 * hstepA;
    const unsigned ldsw = (unsigned)wid * 1024u;
    const int aoff = lds_byte(wr * 64 + fr, fq * 8), boff = lds_byte(wc * 32 + fr, fq * 8);
#define PG8_SA(b, h) (((b) * 2 + (h)) * HTB)
#define PG8_SB(b, h) ((4 + (b) * 2 + (h)) * HTB)
#define PG8_STAGE(bufoff, gbase, voff) do { _Pragma("unroll") for (int _i = 0; _i < 2; ++_i) \
        __builtin_amdgcn_global_load_lds((const unsigned*)((const char*)(gbase) + (voff)[_i]), (PG8_LAS unsigned*)(lds + (bufoff) + ldsw + _i * 8192), 16, 0, 0); } while (0)
#define PG8_LDA(dst, b, h) do { _Pragma("unroll") for (int m = 0; m < 4; ++m) _Pragma("unroll") for (int k = 0; k < 2; ++k) dst[m][k] = *(const PG8_LAS bf16x8*)(lds + PG8_SA(b, h) + aoff + m * 2048 + k * 1024); } while (0)
#define PG8_LDB(dst, b, h) do { _Pragma("unroll") for (int n = 0; n < 2; ++n) _Pragma("unroll") for (int k = 0; k < 2; ++k) dst[n][k] = *(const PG8_LAS bf16x8*)(lds + PG8_SB(b, h) + boff + n * 2048 + k * 1024); } while (0)
#define PG8_MMA(ai, bj, At, Bt) do { __builtin_amdgcn_s_setprio(1); _Pragma("unroll") for (int m = 0; m < 4; ++m) _Pragma("unroll") for (int n = 0; n < 2; ++n) _Pragma("unroll") for (int k = 0; k < 2; ++k) \
        acc[ai][bj][m][n] = __builtin_amdgcn_mfma_f32_16x16x32_bf16(Bt[n][k], At[m][k], acc[ai][bj][m][n], 0, 0, 0); __builtin_amdgcn_s_setprio(0); } while (0)
#define PG8_WAIT_V(n) asm volatile("s_waitcnt vmcnt(" #n ")" ::: "memory")
#define PG8_WAIT_L(n) asm volatile("s_waitcnt lgkmcnt(" #n ")" ::: "memory")
#define PG8_BAR __builtin_amdgcn_s_barrier()
#define PG8_SCHED __builtin_amdgcn_sched_barrier(0)
    Unit cur, nxt; int ui = 0;
    if (!S.next(0, cur)) return;
    f32x4 acc[2][2][4][2];
#pragma unroll
    for (int a = 0; a < 2; ++a)
#pragma unroll
        for (int b = 0; b < 2; ++b)
#pragma unroll
            for (int m = 0; m < 4; ++m)
#pragma unroll
                for (int n = 0; n < 2; ++n) acc[a][b][m][n] = (f32x4){0.f, 0.f, 0.f, 0.f};
    bf16x8 At[4][2], B0[2][2], B1[2][2];
    typename Epi::Pre pre;
    const char* cA = (const char*)g.A + (size_t)cur.pm * tstepA; const char* cB = (const char*)g.Bt + (size_t)cur.pn * tstep;
    S.a_ready(cur);
    if constexpr (SP2) {
        PG8_STAGE(PG8_SB(0, 0), cB, voffB); PG8_STAGE(PG8_SB(0, 1), cB + hstep, voffB); PG8_STAGE(PG8_SA(0, 0), cA, voffA); PG8_STAGE(PG8_SA(0, 1), cA + hstepA, voffA);
        if (wr == 1) PG8_BAR;
        PG8_WAIT_V(2); PG8_BAR;
        PG8_STAGE(PG8_SB(1, 0), cB + kstep, voffB); PG8_STAGE(PG8_SA(1, 0), cA + kstep, voffA); PG8_STAGE(PG8_SB(1, 1), cB + hstep + kstep, voffB);
        PG8_WAIT_V(6); PG8_BAR;
    } else {
        PG8_STAGE(PG8_SB(0, 0), cB, voffB); PG8_STAGE(PG8_SA(0, 0), cA, voffA); PG8_STAGE(PG8_SB(0, 1), cB + hstep, voffB); PG8_STAGE(PG8_SA(0, 1), cA + hstepA, voffA);
        if (wr == 1) PG8_BAR;
        PG8_WAIT_V(4); PG8_BAR;
        PG8_STAGE(PG8_SB(1, 0), cB + kstep, voffB); PG8_STAGE(PG8_SA(1, 0), cA + kstep, voffA); PG8_STAGE(PG8_SB(1, 1), cB + hstep + kstep, voffB);
        PG8_WAIT_V(6); PG8_BAR;
    }
    for (;;) {
        const bool has_next = S.next(ui + 1, nxt);
        const char* nA = has_next ? (const char*)g.A + (size_t)nxt.pm * tstepA : cA; const char* nB = has_next ? (const char*)g.Bt + (size_t)nxt.pn * tstep : cB;
        for (int t = 0; t < nt; t += 2) {
            const bool last = (t == nt - 2);
            const char* a1 = cA + (size_t)(t + 1) * kstep;
            const char* a2 = last ? nA : cA + (size_t)(t + 2) * kstep; const char* b2 = last ? nB : cB + (size_t)(t + 2) * kstep;
            const char* a3 = a2 + kstep; const char* b3 = b2 + kstep;
            if (last && has_next) S.a_ready(nxt);
            if (last) E.prefetch(pre, cur, wr, lane);
            if constexpr (SP2) {
            PG8_LDB(B0, 0, 0); PG8_LDB(B1, 0, 1); PG8_SCHED; PG8_LDA(At, 0, 0); PG8_STAGE(PG8_SA(1, 1), a1 + hstepA, voffA);
            PG8_WAIT_V(8); PG8_WAIT_L(0); PG8_BAR; PG8_MMA(0, 0, At, B0); PG8_MMA(0, 1, At, B1); PG8_BAR; PG8_SCHED;
            PG8_LDA(At, 0, 1); PG8_STAGE(PG8_SB(0, 0), b2, voffB); PG8_STAGE(PG8_SB(0, 1), b2 + hstep, voffB); PG8_STAGE(PG8_SA(0, 0), a2, voffA);
            PG8_WAIT_V(8); PG8_WAIT_L(0); PG8_BAR; PG8_MMA(1, 0, At, B0); PG8_MMA(1, 1, At, B1); PG8_BAR; PG8_SCHED;
            PG8_LDB(B0, 1, 0); PG8_LDB(B1, 1, 1); PG8_SCHED; PG8_LDA(At, 1, 0); PG8_STAGE(PG8_SA(0, 1), a2 + hstepA, voffA);
            PG8_WAIT_V(8); PG8_WAIT_L(0); PG8_BAR; PG8_MMA(0, 0, At, B0); PG8_MMA(0, 1, At, B1); PG8_BAR; PG8_SCHED;
            PG8_LDA(At, 1, 1); PG8_STAGE(PG8_SB(1, 0), b3, voffB); PG8_STAGE(PG8_SB(1, 1), b3 + hstep, voffB); PG8_STAGE(PG8_SA(1, 0), a3, voffA);
            PG8_WAIT_V(8); PG8_WAIT_L(0); PG8_BAR; PG8_MMA(1, 0, At, B0); PG8_MMA(1, 1, At, B1); PG8_BAR; PG8_SCHED;
            } else {
            PG8_LDB(B0, 0, 0); PG8_SCHED; PG8_LDA(At, 0, 0); PG8_STAGE(PG8_SA(1, 1), a1 + hstepA, voffA);
            PG8_WAIT_L(8); PG8_BAR; PG8_WAIT_L(0); PG8_MMA(0, 0, At, B0); PG8_BAR; PG8_SCHED;
            PG8_LDB(B1, 0, 1); PG8_STAGE(PG8_SB(0, 0), b2, voffB);
            PG8_BAR; PG8_WAIT_L(0); PG8_MMA(0, 1, At, B1); PG8_BAR;
            PG8_LDA(At, 0, 1); PG8_STAGE(PG8_SA(0, 0), a2, voffA);
            PG8_BAR; PG8_WAIT_L(0); PG8_MMA(1, 0, At, B0); PG8_BAR; PG8_SCHED;
            PG8_STAGE(PG8_SB(0, 1), b2 + hstep, voffB);
            PG8_WAIT_V(6); PG8_BAR; PG8_MMA(1, 1, At, B1); PG8_BAR;
            PG8_LDB(B0, 1, 0); PG8_SCHED; PG8_LDA(At, 1, 0); PG8_STAGE(PG8_SA(0, 1), a2 + hstepA, voffA);
            PG8_WAIT_L(8); PG8_BAR; PG8_WAIT_L(0); PG8_MMA(0, 0, At, B0); PG8_BAR; PG8_SCHED;
            PG8_LDB(B1, 1, 1); PG8_STAGE(PG8_SB(1, 0), b3, voffB);
            PG8_BAR; PG8_WAIT_L(0); PG8_MMA(0, 1, At, B1); PG8_BAR;
            PG8_LDA(At, 1, 1); PG8_STAGE(PG8_SA(1, 0), a3, voffA);
            PG8_BAR; PG8_WAIT_L(0); PG8_MMA(1, 0, At, B0); PG8_BAR; PG8_SCHED;
            PG8_STAGE(PG8_SB(1, 1), b3 + hstep, voffB);
            PG8_WAIT_V(6); PG8_BAR; PG8_MMA(1, 1, At, B1); PG8_BAR;
            }
        }
        if constexpr (ALIGN_EPI) { if (wr == 0) PG8_BAR; }
        if constexpr (!Epi::AFTER_DRAIN) { E(acc, pre, cur, wr, wc, fr, fq); S.done(cur); }
        if (!has_next) break;
#pragma unroll
        for (int a = 0; a < 2; ++a)
#pragma unroll
            for (int b = 0; b < 2; ++b)
#pragma unroll
                for (int m = 0; m < 4; ++m)
#pragma unroll
                    for (int n = 0; n < 2; ++n) acc[a][b][m][n] = (f32x4){0.f, 0.f, 0.f, 0.f};
        cur = nxt; cA = nA; cB = nB; ++ui;
        if constexpr (ALIGN_EPI) { if (wr == 1) PG8_BAR; }
    }
    PG8_WAIT_V(0);
    if constexpr (!ALIGN_EPI) { if (wr == 0) PG8_BAR; }
    PG8_BAR;
    if constexpr (Epi::AFTER_DRAIN) { E.fused(acc, cur, wr, wc, fr, fq, lds, wid, lane); S.done(cur); asm volatile("s_waitcnt lgkmcnt(0)" ::: "memory"); PG8_BAR; }
#undef PG8_SA
#undef PG8_SB
#undef PG8_STAGE
#undef PG8_LDA
#undef PG8_LDB
#undef PG8_MMA
#undef PG8_WAIT_V
#undef PG8_WAIT_L
#undef PG8_BAR
#undef PG8_SCHED
}
}

#ifndef PG8_SP2
#define PG8_SP2 true
#endif
#ifndef PG8_ALIGN
#define PG8_ALIGN true
#endif

constexpr int NWAVES = 8;
constexpr int N_LAUNCHES = 1;
constexpr int PER_PHASE = 8;
constexpr int M = 16384, D = 1024, FF = 2816, DIN = 1280, SEQ = 2048;
constexpr int NGU = 2 * FF;
constexpr float LOG2E = 1.4426950408889634f;
constexpr float QSCALE = 0.125f * LOG2E;

constexpr size_t MiB = 1u << 20;
constexpr size_t WS_CTL = 0, CTL_ZERO_BYTES = 53248;
constexpr size_t WS_W1GU = 2 * MiB;
constexpr size_t WS_W1D = 14 * MiB;
constexpr size_t WS_WIN = 20 * MiB;
constexpr size_t WS_WOUT = 23 * MiB;
constexpr size_t WS_W2GU = 26 * MiB;
constexpr size_t WS_W2D = 38 * MiB;
constexpr size_t WS_WPOOL = 44 * MiB;
constexpr size_t WS_SS0 = 45 * MiB, WS_SS1 = 46 * MiB, WS_SS2 = 47 * MiB;
constexpr size_t WS_XB = 48 * MiB;
constexpr size_t WS_H = 80 * MiB;
constexpr size_t WS_END = 168 * MiB;
static_assert(WS_H + (size_t)M * FF * 2 <= WS_END && (D + DIN) <= FF, "d_ws map");
constexpr int CW_BAR = 4096;

constexpr int RING_OFF = 0, RING_BYTES = 131072;
constexpr int LDSCTL_OFF = RING_BYTES, MISC_OFF = LDSCTL_OFF + 320;
constexpr int LDS_BYTES = 147456;

#define GAS __attribute__((address_space(1)))
#define LAS __attribute__((address_space(3)))
typedef unsigned short bf16;
typedef unsigned v4u __attribute__((ext_vector_type(4)));
typedef unsigned v2u __attribute__((ext_vector_type(2)));
typedef float f32x4 __attribute__((ext_vector_type(4)));
typedef float f32x16 __attribute__((ext_vector_type(16)));
typedef short bf16x8 __attribute__((ext_vector_type(8)));
typedef short s16x4 __attribute__((ext_vector_type(4)));
typedef GAS unsigned gu32;
#define RLX_AGENT __ATOMIC_RELAXED, __HIP_MEMORY_SCOPE_AGENT
#define LDS_WAIT() asm volatile("s_waitcnt lgkmcnt(0)" ::: "memory")
#define VM_WAIT() asm volatile("s_waitcnt vmcnt(0)" ::: "memory")
__device__ __forceinline__ unsigned f2bf(float f) { unsigned u = __builtin_bit_cast(unsigned, f); return (u + 0x7fffu + ((u >> 16) & 1u)) >> 16; }
__device__ __forceinline__ unsigned pk2(float lo, float hi) { return f2bf(lo) | (f2bf(hi) << 16); }
__device__ __forceinline__ float bf2f(unsigned short b) { return __builtin_bit_cast(float, (unsigned)b << 16); }

#define XB_TMO      128
#define XB_XCNT(j)  (256  + 64 * (j))
#define XB_XSUB(j)  (1280 + 64 * (j))
#define XB_XGEN(j)  (2304 + 64 * (j))
#define XB_TOP      3328
#define XB_TOPGEN   3392
#define XCD_BAR_WORDS 3456
#define XB_PNL(p)   (4544 + 64 * (p))
#define XB_CONV     (3456 + 64 * 16)
#define XB_LOC(j)   (3456 + 64 * (j))
#define XB_SPIN_CAP (1u << 18)
__device__ __forceinline__ unsigned xb_ld(unsigned* p)              { return __hip_atomic_load(p, __ATOMIC_RELAXED, __HIP_MEMORY_SCOPE_AGENT); }
__device__ __forceinline__ unsigned xb_add(unsigned* p, unsigned v) { return __hip_atomic_fetch_add(p, v, __ATOMIC_RELAXED, __HIP_MEMORY_SCOPE_AGENT); }
__device__ __forceinline__ unsigned xb_xcc_id() { return (unsigned)__builtin_amdgcn_s_getreg((3 << 11) | 20) & 0xFu; }
#define XB_SPIN(cond, bar) do { unsigned _sp = 0; while (cond) { __builtin_amdgcn_s_sleep(1); \
    if ((++_sp & 255u) == 0u) { if (xb_ld(&(bar)[XB_TMO])) break; if (_sp > XB_SPIN_CAP) { atomicAdd(&(bar)[XB_TMO], 1u); break; } } } } while (0)
struct XcdBarrier { unsigned* bar; unsigned x; volatile LAS unsigned* st; };
__device__ __forceinline__ XcdBarrier xcd_barrier_post(unsigned* bar, volatile LAS unsigned* st) {
    XcdBarrier b; b.bar = bar; b.x = xb_xcc_id(); b.st = st;
    if (threadIdx.x == 0) st[2] = xb_add(&bar[XB_XCNT(b.x)], 1u);
    return b;
}
__device__ __forceinline__ void xcd_barrier_complete(unsigned* bar, unsigned x, unsigned& nloc, unsigned& nx) {
    const unsigned G = gridDim.x * gridDim.y * gridDim.z;
    unsigned sum, cnt, mine, sp = 0u;
    for (;;) {
        sum = 0u; cnt = 0u; mine = 0u;
#pragma unroll
        for (unsigned j = 0; j < 16; ++j) { const unsigned c = xb_ld(&bar[XB_XCNT(j)]); sum += c; cnt += (c > 0u) ? 1u : 0u; mine = (j == x) ? c : mine; }
        if (sum == G) break;
        __builtin_amdgcn_s_sleep(1);
        if ((++sp & 255u) == 0u) { if (xb_ld(&bar[XB_TMO])) break; if (sp > XB_SPIN_CAP) { atomicAdd(&bar[XB_TMO], 1u); break; } }
    }
    nloc = mine > 0u ? mine : 1u; nx = cnt > 0u ? cnt : 1u;
}
__device__ __forceinline__ bool xcd_topology_regular(unsigned* bar) {
    bool ok = true;
#pragma unroll
    for (unsigned j = 0; j < 16; ++j) { const unsigned c = xb_ld(&bar[XB_XCNT(j)]); ok = ok && (c == (j < 8u ? 32u : 0u)); }
    return ok;
}
__device__ __forceinline__ void xcd_barrier(const XcdBarrier& b) {
    asm volatile("s_waitcnt vmcnt(0)" ::: "memory");
    __syncthreads();
    if (threadIdx.x == 0) {
        unsigned* bar = b.bar;
        __builtin_amdgcn_s_waitcnt(0);
        unsigned nloc = b.st[0], nx = b.st[1];
        if (nloc == 0u) { xcd_barrier_complete(bar, b.x, nloc, nx); b.st[0] = nloc; b.st[1] = nx; b.st[3] = xcd_topology_regular(bar) ? 1u : 2u; }
        const unsigned old = xb_add(&bar[XB_XSUB(b.x)], 1u);
        const unsigned gen = old / nloc;
        if (old + 1u == (gen + 1u) * nloc) {
            __builtin_amdgcn_fence(__ATOMIC_RELEASE, "agent");
            asm volatile("s_waitcnt vmcnt(0)" ::: "memory");
            const unsigned og = xb_add(&bar[XB_TOP], 1u);
            const unsigned tg = og / nx;
            if (og + 1u == (tg + 1u) * nx) xb_add(&bar[XB_TOPGEN], 1u);
            else XB_SPIN(xb_ld(&bar[XB_TOPGEN]) == tg, bar);
            __builtin_amdgcn_fence(__ATOMIC_ACQUIRE, "agent");
            xb_add(&bar[XB_XGEN(b.x)], 1u);
            asm volatile("s_waitcnt vmcnt(0)" ::: "memory");
        } else {
            XB_SPIN(xb_ld(&bar[XB_XGEN(b.x)]) == gen, bar);
            __builtin_amdgcn_fence(__ATOMIC_ACQUIRE, "agent");
            asm volatile("s_waitcnt vmcnt(0)" ::: "memory");
        }
    }
    __syncthreads();
}

__device__ __forceinline__ void xcd_local_barrier(const XcdBarrier& b, unsigned& lgen, unsigned* extra = nullptr, unsigned extra_target = 0u) {
    asm volatile("s_waitcnt vmcnt(0)" ::: "memory");
    __syncthreads();
    if (threadIdx.x == 0) {
        __builtin_amdgcn_s_waitcnt(0);
        unsigned* w = &b.bar[XB_LOC(b.x)];
        (void)xb_add(w, 1u);
        const unsigned target = (lgen + 1u) * 32u;
        XB_SPIN(xb_ld(w) < target, b.bar);
        if (extra) XB_SPIN(xb_ld(extra) < extra_target, b.bar);
        __builtin_amdgcn_fence(__ATOMIC_ACQUIRE, "agent");
        asm volatile("s_waitcnt vmcnt(0)" ::: "memory");
    }
    ++lgen;
    __syncthreads();
}

__device__ __forceinline__ void xcd_panel_barrier(const XcdBarrier& b, unsigned& pgen, int pm, unsigned* extra = nullptr, unsigned extra_target = 0u) {
    asm volatile("s_waitcnt vmcnt(0)" ::: "memory");
    __syncthreads();
    if (threadIdx.x == 0) {
        __builtin_amdgcn_s_waitcnt(0);
        unsigned* w = &b.bar[XB_PNL(pm)];
        (void)xb_add(w, 1u);
        const unsigned target = (pgen + 1u) * 4u;
        XB_SPIN(xb_ld(w) < target, b.bar);
        if (extra) XB_SPIN(xb_ld(extra) < extra_target, b.bar);
        __builtin_amdgcn_fence(__ATOMIC_ACQUIRE, "agent");
        asm volatile("s_waitcnt vmcnt(0)" ::: "memory");
    }
    ++pgen;
    __syncthreads();
}

struct Frame {
    LAS unsigned char* lds;
    volatile LAS unsigned* MISC;
    gu32* ctl;
    int tid, lane, wave;
    int vcu, G;
};
__device__ __forceinline__ float wave_sum(float v) {
#pragma unroll
    for (int o = 1; o < 64; o <<= 1) v += __shfl_xor(v, o);
    return v;
}

__device__ __forceinline__ int dest_row(int mode, int n0) {
    if (mode == 0) return n0;
    if (mode == 1) return 256 * (n0 >> 7) + (n0 & 127);
    if (mode == 2) return 256 * (n0 >> 7) + 128 + (n0 & 127);
    return 256 * (n0 >> 8) + 128 * ((n0 >> 5) & 1) + 32 * ((n0 >> 6) & 3);
}
template <bool WTH = false>
__device__ __forceinline__ void p0_transpose_item(const float* W, int K, int N, bf16* WT, int mode, const float* gain, LAS float* scr, int item, int lane) {
    const int nblk = N / 32, kb = item / nblk, nb = item % nblk, k0 = 64 * kb, n0 = 32 * nb;
    { f32x4 t[8];
#pragma unroll
      for (int i = 0; i < 8; ++i) t[i] = __builtin_nontemporal_load((const f32x4*)(W + (size_t)(k0 + 8 * i + (lane >> 3)) * N + n0 + 4 * (lane & 7)));
#pragma unroll
      for (int i = 0; i < 8; ++i) { LAS float* d = scr + (8 * i + (lane >> 3)) * 33 + 4 * (lane & 7); d[0] = t[i][0]; d[1] = t[i][1]; d[2] = t[i][2]; d[3] = t[i][3]; } }
    LDS_WAIT(); asm volatile("" ::: "memory");
    const int c = lane & 7;
    f32x4 ga = (f32x4){1.f, 1.f, 1.f, 1.f}, gb = ga;
    if (gain) { ga = *(const f32x4*)(gain + k0 + 8 * c); gb = *(const f32x4*)(gain + k0 + 8 * c + 4); }
    const int r0 = dest_row(mode, n0);
    const __amdgpu_buffer_rsrc_t wtr = WT_RSRC(WT);
#pragma unroll
    for (int j = 0; j < 4; ++j) { const int n = (lane >> 3) + 8 * j; const LAS float* s = scr + (8 * c) * 33 + n;
        v4u o; o.x = pk2(s[0 * 33] * ga[0], s[1 * 33] * ga[1]); o.y = pk2(s[2 * 33] * ga[2], s[3 * 33] * ga[3]); o.z = pk2(s[4 * 33] * gb[0], s[5 * 33] * gb[1]); o.w = pk2(s[6 * 33] * gb[2], s[7 * 33] * gb[3]);
        if (WTH) WT_ST16(wtr, ((size_t)(r0 + n) * K + k0 + 8 * c) * 2, o); else *(GAS v4u*)(WT + (size_t)(r0 + n) * K + k0 + 8 * c) = o; }
    LDS_WAIT(); asm volatile("" ::: "memory");
}

namespace mixp {
__device__ const unsigned char kBucket[128] = {0,1,2,3,4,5,6,7,8,9,10,11,12,13,14,15,16,16,16,17,17,18,18,18,19,19,19,20,20,20,20,21,21,21,21,22,22,22,22,22,23,23,23,23,23,23,24,24,24,24,24,24,25,25,25,25,25,25,25,26,26,26,26,26,26,26,26,27,27,27,27,27,27,27,27,27,27,28,28,28,28,28,28,28,28,28,28,29,29,29,29,29,29,29,29,29,29,29,29,30,30,30,30,30,30,30,30,30,30,30,30,30,30,31,31,31,31,31,31,31,31,31,31,31,31,31,31,31};
constexpr int ZP = FF, YP = FF;
constexpr int L_K = 0, L_V = 32768, L_TB = 65536, L_U = 68608, L_PA = 0;
constexpr float NEG = -1e30f;
typedef short v4i16_t __attribute__((ext_vector_type(4)));
__device__ __forceinline__ s16x4 vtr(const LAS unsigned char* p) { return __builtin_bit_cast(s16x4, __builtin_amdgcn_ds_read_tr16_b64_v4i16((LAS v4i16_t*)p)); }
__device__ __forceinline__ unsigned cvtpk(float lo, float hi) { unsigned r; asm volatile("v_cvt_pk_bf16_f32 %0, %1, %2" : "=v"(r) : "v"(lo), "v"(hi)); return r; }

__device__ __forceinline__ int fsw(int r) { return (((r >> 1) & 1) << 2) | ((r >> 2) & 1) | (((r >> 3) & 1) << 1); }
__device__ __forceinline__ void store16_rows(bf16* rowp  , int h2, v2u g0, v2u g1, v2u g2, v2u g3) {
    { const auto rx = __builtin_amdgcn_permlane32_swap(g0.x, g1.x, false, false); const auto ry = __builtin_amdgcn_permlane32_swap(g0.y, g1.y, false, false);
      *(GAS v4u*)(rowp + 8 * h2) = (v4u){rx[0], ry[0], rx[1], ry[1]}; }
    { const auto rx = __builtin_amdgcn_permlane32_swap(g2.x, g3.x, false, false); const auto ry = __builtin_amdgcn_permlane32_swap(g2.y, g3.y, false, false);
      *(GAS v4u*)(rowp + 16 + 8 * h2) = (v4u){rx[0], ry[0], rx[1], ry[1]}; }
}
struct UTile { v4u x[5]; };
__device__ __forceinline__ void utile_load(UTile& U, const bf16* Z, int pu, int tid) {
    const int tile = pu >> 2, g = pu & 3, t0 = tile * 128, s0 = t0 % SEQ;
#pragma unroll
    for (int k = 0; k < 5; ++k) {
        const int chunk = tid + 512 * k, row = chunk >> 4, c = chunk & 15;
        const bool ok = (k < 4 || tid < 256) && (s0 > 0 || row >= 16);
        const int rr = ok ? row : 16;
        const v4u v = *(const GAS v4u*)(Z + (size_t)(t0 - 16 + rr) * ZP + 768 + g * 128 + 8 * c);
        U.x[k] = ok ? v : (v4u){0u, 0u, 0u, 0u};
    }
}
__device__ __forceinline__ void utile_store(const UTile& U, LAS unsigned char* lds, int tid) {
#pragma unroll
    for (int k = 0; k < 5; ++k) { const int chunk = tid + 512 * k; if (k < 4 || tid < 256) *(LAS v4u*)(lds + L_U + chunk * 16) = U.x[k]; }
}

__device__ __forceinline__ void attn_unit(LAS unsigned char* lds, const bf16* Z, bf16* Y, const float* sinks, const float* rel_bias, int unit, int pu0, int tid, int wid, int lane) {
    const int b = unit >> 5, blk = (unit >> 1) & 15, kv = unit & 1;
    const int tok0 = b * SEQ + blk * 128;
    const int g = wid >> 1, rh = wid & 1, h = kv * 4 + g;
    const int q32 = lane & 31, h2 = lane >> 5;
    v4u kk[4], vv[4];
#pragma unroll
    for (int i = 0; i < 4; ++i) {
        const int chunk = tid + 512 * i, row = chunk >> 3, c = chunk & 7;
        const int rr = (blk > 0 || row >= 128) ? row : 128;
        const bf16* src = Z + (size_t)(tok0 - 128 + rr) * ZP + 512 + kv * 64 + c * 8;
        kk[i] = *(const GAS v4u*)(src); vv[i] = *(const GAS v4u*)(src + 128);
    }
    bf16x8 qf[2][4];
#pragma unroll
    for (int jj = 0; jj < 2; ++jj) { const bf16* qp = Z + (size_t)(tok0 + 32 * (2 * rh + jj) + q32) * ZP + h * 64 + 8 * h2;
#pragma unroll
        for (int s = 0; s < 4; ++s) qf[jj][s] = *(const GAS bf16x8*)(qp + 16 * s); }
    UTile U; if (pu0 >= 0) utile_load(U, Z, pu0, tid);
    for (int i = tid; i < 768; i += 512) { const int gg = i / 192, dd = i % 192 - 32; const int dc = dd < 0 ? 0 : (dd > 127 ? 127 : dd); ((LAS float*)(lds + L_TB))[i] = (rel_bias[kBucket[dc] * 8 + kv * 4 + gg] - sinks[kv * 4 + gg]) * LOG2E; }
#pragma unroll
    for (int i = 0; i < 4; ++i) { const int chunk = tid + 512 * i, row = chunk >> 3, c = chunk & 7;
        const int sl = (c ^ fsw(row)) * 16; *(LAS v4u*)(lds + L_K + row * 128 + sl) = kk[i]; *(LAS v4u*)(lds + L_V + row * 128 + sl) = vv[i]; }
    if (pu0 >= 0) utile_store(U, lds, tid);
    LDS_WAIT(); __syncthreads();
    const LAS float* tb = (const LAS float*)(lds + L_TB) + g * 192 + 32 + q32 - 4 * h2;
    int koff[4];
#pragma unroll
    for (int sx = 0; sx < 4; ++sx) koff[sx] = q32 * 128 + (((2 * sx + h2) ^ fsw(q32)) * 16);
    int voff[2][2];
#pragma unroll
    for (int a = 0; a < 2; ++a)
#pragma unroll
        for (int dh = 0; dh < 2; ++dh) { const int vr = 8 * a + 4 * (lane >> 5) + ((lane & 15) >> 2), ch = 4 * dh + 2 * ((lane >> 4) & 1) + ((lane & 3) >> 1);
            voff[a][dh] = vr * 128 + ((ch ^ fsw(vr)) * 16) + 8 * (lane & 1); }
#pragma unroll
    for (int jj = 0; jj < 2; ++jj) {
        const int j = 2 * rh + jj;
        f32x16 S[5];
#pragma unroll
        for (int t = 0; t < 5; ++t) {
            const int kt = j + t;
            if (blk == 0 && kt < 4) {
#pragma unroll
                for (int r = 0; r < 16; ++r) S[t][r] = NEG;
            } else {
                f32x16 a = {};
#pragma unroll
                for (int s = 0; s < 4; ++s) { const bf16x8 kf = *(const LAS bf16x8*)(lds + L_K + 32 * kt * 128 + koff[s]); a = __builtin_amdgcn_mfma_f32_32x32x16_bf16(kf, qf[jj][s], a, 0, 0, 0); }
#pragma unroll
                for (int r = 0; r < 16; ++r) {
                    const int cofs = 128 - 32 * t - ((r & 3) + 8 * (r >> 2));
                    const float v = a[r] + tb[cofs];
                    if (t == 0) a[r] = (cofs + q32 - 4 * h2 <= 127) ? v : NEG;
                    else if (t == 4) a[r] = (cofs + q32 - 4 * h2 >= 0) ? v : NEG;
                    else a[r] = v;
                }
                S[t] = a;
            }
        }
        float lsum = 0.f;
#pragma unroll
        for (int t = 0; t < 5; ++t)
#pragma unroll
            for (int r = 0; r < 16; ++r) { const float p = __builtin_amdgcn_exp2f(S[t][r]); S[t][r] = p; lsum += p; }
        lsum += __shfl_xor(lsum, 32);
        lsum += 1.0f;
        f32x16 o0 = {}, o1 = {};
#pragma unroll
        for (int t = 0; t < 5; ++t) {
            const int kt = j + t;
            if (!(blk == 0 && kt < 4)) {
#pragma unroll
                for (int s = 0; s < 2; ++s) {
                    v4u pw; pw.x = cvtpk(S[t][8 * s + 0], S[t][8 * s + 1]); pw.y = cvtpk(S[t][8 * s + 2], S[t][8 * s + 3]); pw.z = cvtpk(S[t][8 * s + 4], S[t][8 * s + 5]); pw.w = cvtpk(S[t][8 * s + 6], S[t][8 * s + 7]);
                    const bf16x8 pf = __builtin_bit_cast(bf16x8, pw);
                    const LAS unsigned char* vb = lds + L_V + (32 * kt + 16 * s) * 128;
                    const s16x4 a0 = vtr(vb + voff[0][0]), a1 = vtr(vb + voff[1][0]), b0 = vtr(vb + voff[0][1]), b1 = vtr(vb + voff[1][1]);
                    const bf16x8 v0 = (bf16x8){a0[0], a0[1], a0[2], a0[3], a1[0], a1[1], a1[2], a1[3]};
                    const bf16x8 v1 = (bf16x8){b0[0], b0[1], b0[2], b0[3], b1[0], b1[1], b1[2], b1[3]};
                    o0 = __builtin_amdgcn_mfma_f32_32x32x16_bf16(v0, pf, o0, 0, 0, 0);
                    o1 = __builtin_amdgcn_mfma_f32_32x32x16_bf16(v1, pf, o1, 0, 0, 0);
                }
            }
        }
        const float rl = 1.0f / lsum;
        bf16* yp = Y + (size_t)(tok0 + 32 * j + q32) * YP + h * 64;
        v2u w0[4], w1[4];
#pragma unroll
        for (int rg = 0; rg < 4; ++rg) {
            w0[rg].x = cvtpk(o0[4 * rg + 0] * rl, o0[4 * rg + 1] * rl); w0[rg].y = cvtpk(o0[4 * rg + 2] * rl, o0[4 * rg + 3] * rl);
            w1[rg].x = cvtpk(o1[4 * rg + 0] * rl, o1[4 * rg + 1] * rl); w1[rg].y = cvtpk(o1[4 * rg + 2] * rl, o1[4 * rg + 3] * rl);
        }
        store16_rows(yp, h2, w0[0], w0[1], w0[2], w0[3]); store16_rows(yp + 32, h2, w1[0], w1[1], w1[2], w1[3]);
    }
    LDS_WAIT(); __syncthreads();
}

__device__ __forceinline__ void pool_stage(LAS unsigned char* lds, const bf16* Z, int pu, int tid) { UTile U; utile_load(U, Z, pu, tid); utile_store(U, lds, tid); LDS_WAIT(); __syncthreads(); }
__device__ __forceinline__ void pool_unit(LAS unsigned char* lds, const bf16* Z, bf16* Y, const bf16* WpT, const float* pscale, int pu, int pu_next, int tid, int wid, int lane) {
    const int tile = pu >> 2, g = pu & 3, t0 = tile * 128, s0 = t0 % SEQ, w = 2 << g;
    const int wr4 = wid >> 1, wcn = wid & 1, q32 = lane & 31, h2 = lane >> 5;
    bf16x8 wf[2][8];
    { const bf16* wp = WpT + (size_t)g * 128 * 128 + (size_t)(64 * wcn + q32) * 128 + 8 * h2;
#pragma unroll
      for (int s = 0; s < 8; ++s) { wf[0][s] = *(const GAS bf16x8*)(wp + 16 * s); wf[1][s] = *(const GAS bf16x8*)(wp + 32 * 128 + 16 * s); } }
    {
        const int cv = tid & 15, seg = tid >> 4;
        const LAS unsigned char* ub = lds + L_U + (16 + 4 * seg) * 256 + cv * 16;
        float sum[8];
#pragma unroll
        for (int e = 0; e < 8; ++e) sum[e] = 0.f;
        for (int jx = 0; jx < w; ++jx) {
            const v4u x = *(const LAS v4u*)(ub - jx * 256);
#pragma unroll
            for (int e = 0; e < 4; ++e) { sum[2 * e] += bf2f((unsigned short)(x[e] & 0xffffu)); sum[2 * e + 1] += bf2f((unsigned short)(x[e] >> 16)); }
        }
#pragma unroll
        for (int i = 0; i < 4; ++i) {
            const int tt = 4 * seg + i;
            const v4u xc = *(const LAS v4u*)(ub + i * 256);
            float cur[8];
#pragma unroll
            for (int e = 0; e < 4; ++e) { cur[2 * e] = bf2f((unsigned short)(xc[e] & 0xffffu)); cur[2 * e + 1] = bf2f((unsigned short)(xc[e] >> 16)); }
            if (i > 0) {
                const v4u xo = *(const LAS v4u*)(ub + (i - w) * 256);
#pragma unroll
                for (int e = 0; e < 4; ++e) { sum[2 * e] += cur[2 * e] - bf2f((unsigned short)(xo[e] & 0xffffu)); sum[2 * e + 1] += cur[2 * e + 1] - bf2f((unsigned short)(xo[e] >> 16)); }
            }
            const int cn = (s0 + tt + 1) < w ? (s0 + tt + 1) : w; const float ic = 1.0f / (float)cn;
            v4u o;
            o.x = cvtpk(sum[0] * ic - cur[0], sum[1] * ic - cur[1]); o.y = cvtpk(sum[2] * ic - cur[2], sum[3] * ic - cur[3]);
            o.z = cvtpk(sum[4] * ic - cur[4], sum[5] * ic - cur[5]); o.w = cvtpk(sum[6] * ic - cur[6], sum[7] * ic - cur[7]);
            *(LAS v4u*)(lds + L_PA + tt * 256 + ((cv ^ (tt & 15)) * 16)) = o;
        }
    }
    LDS_WAIT(); __syncthreads();
    UTile U; if (pu_next >= 0) utile_load(U, Z, pu_next, tid);
    {
        f32x16 acc0 = {}, acc1 = {};
        const int prow = 32 * wr4 + q32;
#pragma unroll
        for (int s = 0; s < 8; ++s) {
            const bf16x8 pf = *(const LAS bf16x8*)(lds + L_PA + prow * 256 + (((2 * s + h2) ^ (prow & 15)) * 16));
            acc0 = __builtin_amdgcn_mfma_f32_32x32x16_bf16(wf[0][s], pf, acc0, 0, 0, 0);
            acc1 = __builtin_amdgcn_mfma_f32_32x32x16_bf16(wf[1][s], pf, acc1, 0, 0, 0);
        }
        bf16* yp = Y + (size_t)(t0 + prow) * YP + 512 + g * 128 + 64 * wcn;
        const float* sp = pscale + g * 128 + 64 * wcn + 4 * h2;
        v2u a[4], c[4];
#pragma unroll
        for (int rg = 0; rg < 4; ++rg) {
            const f32x4 s0v = *(const f32x4*)(sp + 8 * rg), s1v = *(const f32x4*)(sp + 32 + 8 * rg);
            a[rg].x = cvtpk(acc0[4 * rg + 0] * s0v[0], acc0[4 * rg + 1] * s0v[1]); a[rg].y = cvtpk(acc0[4 * rg + 2] * s0v[2], acc0[4 * rg + 3] * s0v[3]);
            c[rg].x = cvtpk(acc1[4 * rg + 0] * s1v[0], acc1[4 * rg + 1] * s1v[1]); c[rg].y = cvtpk(acc1[4 * rg + 2] * s1v[2], acc1[4 * rg + 3] * s1v[3]);
        }
        store16_rows(yp, h2, a[0], a[1], a[2], a[3]); store16_rows(yp + 32, h2, c[0], c[1], c[2], c[3]);
    }
    if (pu_next >= 0) utile_store(U, lds, tid);
    LDS_WAIT(); __syncthreads();
}
}

struct Args { const float* in[18]; float* out; unsigned char* ws; int ph_lo, ph_hi, li, pad; };
__global__ void __launch_bounds__(NWAVES * 64, 2) mega_fwd(Args args) {
    extern __shared__ __attribute__((aligned(16))) unsigned char lds[];
    Frame F;
    F.lds = (LAS unsigned char*)lds;
    F.MISC = (volatile LAS unsigned*)(F.lds + MISC_OFF);
    F.tid = threadIdx.x; F.lane = F.tid & 63; F.wave = __builtin_amdgcn_readfirstlane(F.tid >> 6);
    F.G = gridDim.x; { const int bx = blockIdx.x; F.vcu = (F.G % 8 == 0) ? (bx % 8) * (F.G / 8) + bx / 8 : bx; }
    unsigned char* ws = args.ws;
    F.ctl = (gu32*)(ws + WS_CTL);
    const float* x = args.in[0];
    const float *ffn1_norm = args.in[1], *ffn1_wg = args.in[2], *ffn1_wu = args.in[3], *ffn1_wd = args.in[4], *mix_norm = args.in[5], *w_in = args.in[6], *q_norm = args.in[7], *k_norm = args.in[8];
    const float *sinks = args.in[9], *rel_bias = args.in[10], *pool_w = args.in[11], *pool_scale = args.in[12], *w_out = args.in[13], *ffn2_norm = args.in[14], *ffn2_wg = args.in[15], *ffn2_wu = args.in[16], *ffn2_wd = args.in[17];
    float* out = args.out;
    bf16 *W1GU = (bf16*)(ws + WS_W1GU), *W1D = (bf16*)(ws + WS_W1D), *WIN = (bf16*)(ws + WS_WIN), *WOUT = (bf16*)(ws + WS_WOUT), *W2GU = (bf16*)(ws + WS_W2GU), *W2D = (bf16*)(ws + WS_W2D), *WPOOL = (bf16*)(ws + WS_WPOOL);
    float *SS0 = (float*)(ws + WS_SS0), *SS1 = (float*)(ws + WS_SS1), *SS2 = (float*)(ws + WS_SS2);
    bf16 *XB = (bf16*)(ws + WS_XB), *HB = (bf16*)(ws + WS_H), *YB = (bf16*)(ws + WS_H), *ZB = (bf16*)(ws + WS_H) + D;

    for (int u = F.tid; u < (LDS_BYTES - LDSCTL_OFF) / 4; u += NWAVES * 64) ((LAS unsigned*)(F.lds + LDSCTL_OFF))[u] = 0u;
    __syncthreads();
    const int bli = (N_LAUNCHES == PER_PHASE) ? 0 : args.li;
    XcdBarrier bar; bar.bar = (unsigned*)(F.ctl + CW_BAR) + bli * XCD_BAR_WORDS; bar.x = 0; bar.st = nullptr;
    if (N_LAUNCHES != PER_PHASE) bar = xcd_barrier_post((unsigned*)(F.ctl + CW_BAR) + bli * XCD_BAR_WORDS, F.MISC + 8);
#define GRID_BAR() do { if (N_LAUNCHES != PER_PHASE) xcd_barrier(bar); } while (0)
    unsigned lgen = 0u; bool topo = false; int cid = (int)blockIdx.x;
#define LOCAL_BAR() do { if (topo) xcd_local_barrier(bar, lgen); else xcd_barrier(bar); } while (0)
    unsigned pgen = 0u;
#define PANEL_BAR() do { if (topo) xcd_panel_barrier(bar, pgen, 8 * (cid & 7) + ((cid >> 3) & 7)); else xcd_barrier(bar); } while (0)
    const int lo = args.ph_lo, hi = args.ph_hi;
#define IN(k) (lo <= (k) && (k) < hi)
#define BOTH(k) (IN(k) && IN((k) + 1))

    if (IN(0)) { for (int rep_ = 0; rep_ < NREP(0); ++rep_) {
        LAS float* scr = (LAS float*)(F.lds + RING_OFF + F.wave * 16384);
        const int gw = F.vcu * NWAVES + F.wave, NGW = F.G * NWAVES;
        constexpr int I_GU = (D / 64) * (FF / 32);
        for (int it = gw; it < 2 * I_GU; it += NGW) {
            if (it < I_GU) p0_transpose_item(ffn1_wg, D, FF, W1GU, 1, ffn1_norm, scr, it, F.lane);
            else p0_transpose_item(ffn1_wu, D, FF, W1GU, 2, ffn1_norm, scr, it - I_GU, F.lane);
        }
        for (int m = gw; m < M; m += NGW) {
            const GAS f32x4* xr = (const GAS f32x4*)(x + (size_t)m * D) + F.lane;
            f32x4 v[4]; float s = 0.f;
#pragma unroll
            for (int j = 0; j < 4; ++j) { v[j] = __builtin_nontemporal_load(xr + 64 * j); s += (v[j].x * v[j].x + v[j].y * v[j].y) + (v[j].z * v[j].z + v[j].w * v[j].w); }
            s = wave_sum(s);
            GAS unsigned long long* o8 = (GAS unsigned long long*)(XB + (size_t)m * D) + F.lane;
#pragma unroll
            for (int j = 0; j < 4; ++j) o8[64 * j] = (unsigned long long)pk2(v[j].x, v[j].y) | ((unsigned long long)pk2(v[j].z, v[j].w) << 32);
            if (F.lane < 4) SS0[(size_t)m * 4 + F.lane] = F.lane == 0 ? s : 0.f;
        } }
        if (BOTH(0)) GRID_BAR();
        for (int xb_ = 0; xb_ < PROBE_XBAR; ++xb_) GRID_BAR();
        topo = (F.MISC[11] == 1u) && F.G == 256;
        if (topo) cid = (int)(F.MISC[10] * 8u + bar.x);
    }
    if (IN(1)) {
        if (cid >= ((M / 256) * (NGU / 256)) % F.G) {
            const int nlo = ((M / 256) * (NGU / 256)) % F.G, ncv = F.G - nlo;
            LAS float* scr = (LAS float*)(F.lds + RING_OFF + F.wave * 16384);
            const int gw = (cid - nlo) * NWAVES + F.wave, NGW = ncv * NWAVES;
            constexpr int I_GU = (D / 64) * (FF / 32), I_DN = (FF / 64) * (D / 32), I_IN = (D / 64) * (DIN / 32), I_OUT = (D / 64) * (D / 32), I_PL = (128 / 64) * (128 / 32);
            constexpr int NITEMS = 2 * I_GU + 2 * I_DN + I_IN + I_OUT + 4 * I_PL;
            for (int it = gw; it < NITEMS; it += NGW) {
                int r = it;
                if (r < I_DN) { p0_transpose_item<true>(ffn1_wd, FF, D, W1D, 0, nullptr, scr, r, F.lane); continue; } r -= I_DN;
                if (r < I_IN) { p0_transpose_item<true>(w_in, D, DIN, WIN, 3, mix_norm, scr, r, F.lane); continue; } r -= I_IN;
                if (r < I_OUT) { p0_transpose_item<true>(w_out, D, D, WOUT, 0, nullptr, scr, r, F.lane); continue; } r -= I_OUT;
                if (r < 4 * I_PL) { const int gp = r / I_PL; p0_transpose_item<true>(pool_w + (size_t)gp * 128 * 128, 128, 128, WPOOL + (size_t)gp * 128 * 128, 0, nullptr, scr, r % I_PL, F.lane); continue; } r -= 4 * I_PL;
                if (r < I_GU) { p0_transpose_item<true>(ffn2_wg, D, FF, W2GU, 1, ffn2_norm, scr, r, F.lane); continue; } r -= I_GU;
                if (r < I_GU) { p0_transpose_item<true>(ffn2_wu, D, FF, W2GU, 2, ffn2_norm, scr, r, F.lane); continue; } r -= I_GU;
                p0_transpose_item<true>(ffn2_wd, FF, D, W2D, 0, nullptr, scr, r, F.lane);
            }
            LDS_WAIT(); asm volatile("s_waitcnt vmcnt(0)" ::: "memory");
            __syncthreads();
            if (F.tid == 0) (void)xb_add(&bar.bar[XB_CONV], 1u);
        }
        pg8::Gemm g{XB, W1GU, M, NGU, D}; pg8::StaticOrder S; S.init(M, NGU, F.G, cid);
        pg8::EpiSwiGLU E{HB, FF, SS0};
        for (int rep_ = 0; rep_ < NREP(1); ++rep_) pg8::gemm_phase<pg8::EpiSwiGLU, pg8::StaticOrder, PG8_ALIGN, PG8_SP2>(F.lds + RING_OFF, g, S, E);
        if (BOTH(1)) { if (topo) xcd_panel_barrier(bar, pgen, 8 * (cid & 7) + ((cid >> 3) & 7), &bar.bar[XB_CONV], (unsigned)(F.G - ((M / 256) * (NGU / 256)) % F.G)); else xcd_barrier(bar); }
    }
    if (IN(2)) {
        pg8::Gemm g{HB, W1D, M, D, FF}; pg8::StaticOrder S; S.init(M, D, F.G, cid);
        pg8::EpiResid<true, true> E{nullptr, XB, nullptr, XB, SS1, 0.5f};
        pg8::gemm_phase<pg8::EpiResid<true, true>, pg8::StaticOrder, PG8_ALIGN, PG8_SP2>(F.lds + RING_OFF, g, S, E);
        if (BOTH(2)) PANEL_BAR();
    }
    if (IN(3)) {
        pg8::Gemm g{XB, WIN, M, DIN, D}; pg8::StaticOrder S; S.init(M, DIN, F.G, cid); S.r1 = 1;
        pg8::EpiZ E{ZB, FF, SS1, q_norm, k_norm, QSCALE};
        pg8::gemm_phase<pg8::EpiZ, pg8::StaticOrder, PG8_ALIGN, PG8_SP2>(F.lds + RING_OFF, g, S, E);
        if (BOTH(3)) LOCAL_BAR();
    }
    if (IN(4)) {
        const int xb_ = cid & 7, rk = cid >> 3;
        if (rk < 8) {
            pg8::Gemm g{XB, WIN, M, DIN, D}; pg8::StaticOrder S; S.init(M, DIN, F.G, cid); S.r0 = 1; S.r1 = 2;
            pg8::EpiZ E{ZB, FF, SS1, q_norm, k_norm, QSCALE};
            pg8::gemm_phase<pg8::EpiZ, pg8::StaticOrder, PG8_ALIGN, PG8_SP2>(F.lds + RING_OFF, g, S, E);
        } else if (rk < 16) {
            const int a = rk - 8;
            mixp::attn_unit(F.lds + RING_OFF, ZB, YB, sinks, rel_bias, 32 * xb_ + 2 * a, -1, F.tid, F.wave, F.lane);
            mixp::attn_unit(F.lds + RING_OFF, ZB, YB, sinks, rel_bias, 32 * xb_ + 2 * a + 1, -1, F.tid, F.wave, F.lane);
        } else {
            const int p = rk - 16, pu0 = 4 * (16 * xb_ + p), pu1 = pu0 + 1;
            mixp::attn_unit(F.lds + RING_OFF, ZB, YB, sinks, rel_bias, 32 * xb_ + 16 + p, pu0, F.tid, F.wave, F.lane);
            mixp::pool_unit(F.lds + RING_OFF, ZB, YB, WPOOL, pool_scale, pu0, pu1, F.tid, F.wave, F.lane);
            mixp::pool_unit(F.lds + RING_OFF, ZB, YB, WPOOL, pool_scale, pu1, -1, F.tid, F.wave, F.lane);
        }
        if (BOTH(4)) LOCAL_BAR();
    }
    if (IN(5)) {
        pg8::Gemm g{YB, WOUT, M, D, D, FF}; pg8::StaticOrder S; S.init(M, D, F.G, cid);
        { pg8::Unit u0; S.next(0, u0);
          const int pu = 4 * (2 * u0.pm + (u0.pn >> 1)) + 2 + (u0.pn & 1);
          mixp::pool_stage(F.lds + RING_OFF, ZB, pu, F.tid);
          mixp::pool_unit(F.lds + RING_OFF, ZB, YB, WPOOL, pool_scale, pu, -1, F.tid, F.wave, F.lane);
          PANEL_BAR(); }
        pg8::EpiResid<true, true> E{nullptr, XB, nullptr, XB, SS2, 1.0f};
        pg8::gemm_phase<pg8::EpiResid<true, true>, pg8::StaticOrder, PG8_ALIGN, PG8_SP2>(F.lds + RING_OFF, g, S, E);
        if (BOTH(5)) { if (topo) { const int pm_ = 8 * (cid & 7) + ((cid >> 3) & 7); const bool nxt_ = (pm_ & 7) != 7;
                                   xcd_panel_barrier(bar, pgen, pm_, nxt_ ? &bar.bar[XB_PNL(pm_ + 1)] : nullptr, 12u); } else xcd_barrier(bar); }
    }
    if (IN(6)) {
        pg8::Gemm g{XB, W2GU, M, NGU, D}; pg8::StaticOrder S; S.init(M, NGU, F.G, cid);
        pg8::EpiSwiGLU E{HB, FF, SS2};
        for (int rep_ = 0; rep_ < NREP(6); ++rep_) pg8::gemm_phase<pg8::EpiSwiGLU, pg8::StaticOrder, PG8_ALIGN, PG8_SP2>(F.lds + RING_OFF, g, S, E);
        if (BOTH(6)) PANEL_BAR();
    }
    if (IN(7)) {
        pg8::Gemm g{HB, W2D, M, D, FF}; pg8::StaticOrder S; S.init(M, D, F.G, cid);
        pg8::EpiResid<true, false> E{nullptr, XB, out, nullptr, nullptr, 0.5f};
        for (int rep_ = 0; rep_ < NREP(7); ++rep_) pg8::gemm_phase<pg8::EpiResid<true, false>, pg8::StaticOrder, PG8_ALIGN, PG8_SP2>(F.lds + RING_OFF, g, S, E);
    }
#undef IN
#undef BOTH
#undef GRID_BAR
}

extern "C" void kernel_launch(void* const* d_in, const int* in_sizes, int n_in, void* d_out, int out_size, void* d_ws, size_t ws_size, hipStream_t stream) {
    static int grid = 0;
    if (grid == 0) {
        if (n_in != 18 || in_sizes[0] != M * D || out_size != M * D || ws_size < WS_END) { fprintf(stderr, "kernel_launch: unexpected shapes (n_in %d, in0 %d, out %d, ws %zu); nothing launched\n", n_in, n_in > 0 ? in_sizes[0] : -1, out_size, ws_size); grid = -1; return; }
        int dev = 0, cus = 0, per_cu = 0;
        if (hipGetDevice(&dev) != hipSuccess || hipDeviceGetAttribute(&cus, hipDeviceAttributeMultiprocessorCount, dev) != hipSuccess) { grid = -1; return; }
        if (hipFuncSetAttribute((const void*)mega_fwd, hipFuncAttributeMaxDynamicSharedMemorySize, LDS_BYTES) != hipSuccess) { fprintf(stderr, "kernel_launch: hipFuncSetAttribute failed\n"); grid = -1; return; }
        if (hipOccupancyMaxActiveBlocksPerMultiprocessor(&per_cu, (const void*)mega_fwd, NWAVES * 64, LDS_BYTES) != hipSuccess || per_cu < 1)
            fprintf(stderr, "kernel_launch: note: occupancy query reports %d workgroups per CU\n", per_cu);
        (void)hipGetLastError();
        grid = cus;
        if (grid != 256) fprintf(stderr, "kernel_launch: note: %d CUs (tuned for 256)\n", grid);
    }
    if (grid < 0) return;
    if (hipMemsetAsync((char*)d_ws + WS_CTL, 0, CTL_ZERO_BYTES, stream) != hipSuccess) { fprintf(stderr, "kernel_launch: hipMemsetAsync failed\n"); return; }
    Args a{};
    for (int i = 0; i < 18; ++i) a.in[i] = (const float*)d_in[i];
    a.out = (float*)d_out; a.ws = (unsigned char*)d_ws;
    for (int li = 0; li < N_LAUNCHES; ++li) {
        if (N_LAUNCHES == PER_PHASE) { a.ph_lo = li; a.ph_hi = li + 1; } else { a.ph_lo = 0; a.ph_hi = PER_PHASE; }
        a.li = li;
        hipLaunchKernelGGL(mega_fwd, dim3(grid), dim3(NWAVES * 64), LDS_BYTES, stream, a);
        const hipError_t le = hipPeekAtLastError();
        if (le != hipSuccess) { fprintf(stderr, "kernel_launch: launch %d failed: %s\n", li, hipGetErrorName(le)); break; }
    }
}
```

```cpp
#include <hip/hip_runtime.h>
#include <cstdio>
#include <cstdint>

#ifndef MK_N_LAUNCHES
#define MK_N_LAUNCHES 1
#endif
#ifndef PROBE_REP
#define PROBE_REP -1
#endif
#ifndef PROBE_XBAR
#define PROBE_XBAR 0
#endif
#define NREP(k) ((k) == PROBE_REP ? 2 : 1)
#define rep_first(k) true

namespace pg8 {
#define PG8_LAS __attribute__((address_space(3)))
typedef unsigned short bf16_t;
typedef short bf16x8 __attribute__((ext_vector_type(8)));
typedef float f32x4 __attribute__((ext_vector_type(4)));
typedef unsigned u32x4 __attribute__((ext_vector_type(4)));
typedef unsigned u32x2 __attribute__((ext_vector_type(2)));
constexpr int BM = 256, BK = 64, HALF = 128, HTB = HALF * BK * 2, STAGE_BYTES = 8 * HTB, NXCD = 8, WGM = 8;

__host__ __device__ __forceinline__ int lds_byte(int r, int c) { const int st = (r >> 4) * 2 + (c >> 5), rr = r & 15, cc = c & 31, ob = rr * 64 + cc * 2; return st * 1024 + (ob ^ (((ob >> 9) & 1) << 5)); }
__host__ __device__ __forceinline__ void stage_rc(int b, int& R, int& C) { const int st = b / 1024, sb = b % 1024, swz = sb ^ (((sb >> 9) & 1) << 5); R = (st >> 1) * 16 + swz / 64; C = (st & 1) * 32 + (swz % 64) / 2; }
__host__ __device__ __forceinline__ int perm32(int rho) { const int n = rho >> 4, i = rho & 15; return 8 * (i >> 2) + 4 * n + (i & 3); }

struct Unit { int pm, pn; };
struct Gemm { const bf16_t* A; const bf16_t* Bt; int M, N, K; int lda = 0; };

struct StaticOrder {
    int nM, nN, nwg, G, c, r0 = 0, r1 = 1 << 20;
    __host__ __device__ void init(int M, int N, int G_, int c_) { nM = M / BM; nN = N / BM; nwg = nM * nN; G = G_; c = c_; }
    __host__ __device__ bool next(int i, Unit& u) const {
        if (r0 + i >= r1) return false;
        const long L = (long)(r0 + i) * G + c; if (L >= nwg) return false;
        int wgid = (int)L; { const int q = nwg / NXCD, r = nwg % NXCD, xcd = wgid % NXCD, off = wgid / NXCD; wgid = (xcd < r ? xcd * (q + 1) : r * (q + 1) + (xcd - r) * q) + off; }
        const int nig = WGM * nN, gid = wgid / nig, fm = gid * WGM, gsz = (nM - fm) < WGM ? (nM - fm) : WGM;
        u.pm = fm + ((wgid % nig) % gsz); u.pn = (wgid % nig) / gsz; return true;
    }
    __device__ __forceinline__ void a_ready(const Unit&) const {}
    __device__ __forceinline__ void done(const Unit&) const {}
};

#define WT_RSRC(p) __builtin_amdgcn_make_buffer_rsrc((void*)(p), 0, 0x7ffffff0, 0x00020000)
#define WT_ST16(rs, byteoff, v) __builtin_amdgcn_raw_buffer_store_b128((v), (rs), (int)(byteoff), 0, 16)
__device__ __forceinline__ unsigned cvt_pk_bf16(float lo, float hi) { unsigned r; asm volatile("v_cvt_pk_bf16_f32 %0, %1, %2" : "=v"(r) : "v"(lo), "v"(hi)); return r; }

struct RstdPre { f32x4 t[2]; };
struct NoPre {};
__device__ __forceinline__ void rstd_prefetch(RstdPre& p, const float* ss, int rowbase, int lane) {
    p.t[0] = *(const f32x4*)(ss + (size_t)(rowbase + lane) * 4); p.t[1] = *(const f32x4*)(ss + (size_t)(rowbase + 128 + lane) * 4);
}
__device__ __forceinline__ void rstd_finish(const RstdPre& p, int fr, float (&rs)[2][4]) {
    float v[2];
#pragma unroll
    for (int ai = 0; ai < 2; ++ai) { const f32x4 a = p.t[ai]; v[ai] = __builtin_amdgcn_rsqf(((a[0] + a[1]) + (a[2] + a[3])) * (1.0f / 1024.0f) + 1e-6f); }
#pragma unroll
    for (int ai = 0; ai < 2; ++ai)
#pragma unroll
        for (int m = 0; m < 4; ++m) rs[ai][m] = __shfl(v[ai], 16 * m + fr);
}

struct EpiSwiGLU {
    static constexpr bool PERM = true, AFTER_DRAIN = false;
    typedef RstdPre Pre;
    bf16_t* H; int ldh; const float* ss;
    __device__ __forceinline__ void prefetch(Pre& p, const Unit& u, int wr, int lane) const { rstd_prefetch(p, ss, u.pm * BM + wr * 64, lane); }
    __device__ __forceinline__ void operator()(const f32x4 (&acc)[2][2][4][2], const Pre& p, const Unit& u, int wr, int wc, int fr, int fq) const {
        const int row0 = u.pm * BM + wr * 64 + fr, col0 = u.pn * HALF + wc * 32 + 8 * fq;
        float rsv[2][4]; rstd_finish(p, fr, rsv);
#pragma unroll
        for (int ai = 0; ai < 2; ++ai)
#pragma unroll
            for (int m = 0; m < 4; ++m) {
                const int row = row0 + ai * HALF + m * 16; const float rs = rsv[ai][m], c1 = rs * -1.4426950408889634f, rs2 = rs * rs;
                f32x4 h[2];
#pragma unroll
                for (int n = 0; n < 2; ++n) {
                    const f32x4 g = acc[ai][0][m][n], uu = acc[ai][1][m][n];
                    const f32x4 t = g * c1;
                    f32x4 e; e[0] = __builtin_amdgcn_exp2f(t[0]); e[1] = __builtin_amdgcn_exp2f(t[1]); e[2] = __builtin_amdgcn_exp2f(t[2]); e[3] = __builtin_amdgcn_exp2f(t[3]);
                    const f32x4 d = e + 1.0f;
                    f32x4 r; r[0] = __builtin_amdgcn_rcpf(d[0]); r[1] = __builtin_amdgcn_rcpf(d[1]); r[2] = __builtin_amdgcn_rcpf(d[2]); r[3] = __builtin_amdgcn_rcpf(d[3]);
                    h[n] = ((g * uu) * rs2) * r;
                }
                u32x4 w;
                w.x = cvt_pk_bf16(h[0][0], h[0][1]); w.y = cvt_pk_bf16(h[0][2], h[0][3]); w.z = cvt_pk_bf16(h[1][0], h[1][1]); w.w = cvt_pk_bf16(h[1][2], h[1][3]);
                *(u32x4*)(H + (size_t)row * ldh + col0) = w;
            }
    }
};
struct EpiZ {
    static constexpr bool PERM = true, AFTER_DRAIN = false;
    typedef RstdPre Pre;
    bf16_t* Z; int ldz; const float* ss; const float* qg; const float* kg; float qscale;
    __device__ __forceinline__ void prefetch(Pre& p, const Unit& u, int wr, int lane) const { rstd_prefetch(p, ss, u.pm * BM + wr * 64, lane); }
    __device__ __forceinline__ void operator()(const f32x4 (&acc)[2][2][4][2], const Pre& p, const Unit& u, int wr, int wc, int fr, int fq) const {
        const int row0 = u.pm * BM + wr * 64 + fr, slot = u.pn * 4 + wc, col0 = slot * 64 + 8 * fq;
        const int kind = slot < 8 ? 0 : (slot < 10 ? 1 : 2);
        f32x4 gv[2][2];
#pragma unroll
        for (int bj = 0; bj < 2; ++bj)
#pragma unroll
            for (int n = 0; n < 2; ++n) {
                if (kind < 2) { const f32x4 t = *(const f32x4*)((kind == 0 ? qg : kg) + 32 * bj + 8 * fq + 4 * n); gv[bj][n] = kind == 0 ? t * qscale : t; }
                else gv[bj][n] = (f32x4){1.f, 1.f, 1.f, 1.f};
            }
        float rsv[2][4]; rstd_finish(p, fr, rsv);
#pragma unroll
        for (int ai = 0; ai < 2; ++ai)
#pragma unroll
            for (int m = 0; m < 4; ++m) {
                const int row = row0 + ai * HALF + m * 16; const float rs = rsv[ai][m];
                f32x4 v[2][2]; float q = 0.f;
#pragma unroll
                for (int bj = 0; bj < 2; ++bj)
#pragma unroll
                    for (int n = 0; n < 2; ++n) { v[bj][n] = acc[ai][bj][m][n] * rs; const f32x4 t = v[bj][n]; q += (t[0] * t[0] + t[1] * t[1]) + (t[2] * t[2] + t[3] * t[3]); }
                if (kind < 2) {
                    q += __shfl_xor(q, 16); q += __shfl_xor(q, 32);
                    const float rn = __builtin_amdgcn_rsqf(q * (1.0f / 64.0f) + 1e-6f);
#pragma unroll
                    for (int bj = 0; bj < 2; ++bj)
#pragma unroll
                        for (int n = 0; n < 2; ++n) v[bj][n] = v[bj][n] * rn * gv[bj][n];
                }
#pragma unroll
                for (int bj = 0; bj < 2; ++bj) {
                    u32x4 w; w.x = cvt_pk_bf16(v[bj][0][0], v[bj][0][1]); w.y = cvt_pk_bf16(v[bj][0][2], v[bj][0][3]); w.z = cvt_pk_bf16(v[bj][1][0], v[bj][1][1]); w.w = cvt_pk_bf16(v[bj][1][2], v[bj][1][3]);
                    *(u32x4*)(Z + (size_t)row * ldz + col0 + 32 * bj) = w;
                }
            }
    }
};
template <bool RBF, bool OBF> struct EpiResid {
    static constexpr bool PERM = true, AFTER_DRAIN = OBF;
    typedef NoPre Pre;
    const float* R; const bf16_t* Rb; float* out; bf16_t* xb; float* ss; float alpha;
    __device__ __forceinline__ void prefetch(Pre&, const Unit&, int, int) const {}
    __device__ __forceinline__ void operator()(const f32x4 (&acc)[2][2][4][2], const Pre&, const Unit& u, int wr, int wc, int fr, int fq) const { body(acc, u, wr, wc, fr, fq, nullptr); }
    __device__ __forceinline__ void fused(const f32x4 (&acc)[2][2][4][2], const Unit& u, int wr, int wc, int fr, int fq, PG8_LAS unsigned char* lds, int wid, int lane) const {
        body(acc, u, wr, wc, fr, fq, (PG8_LAS float*)lds);
        asm volatile("s_waitcnt lgkmcnt(0)" ::: "memory"); __builtin_amdgcn_s_barrier(); asm volatile("" ::: "memory");
        const int t = wid * 64 + lane;
        if (t < 256) { const f32x4 p = ((const PG8_LAS f32x4*)lds)[t]; ss[(size_t)(u.pm * BM + t) * 4 + u.pn] = (p[0] + p[1]) + (p[2] + p[3]); }
    }
    __device__ __forceinline__ void body(const f32x4 (&acc)[2][2][4][2], const Unit& u, int wr, int wc, int fr, int fq, PG8_LAS float* P) const {
        const int row0 = u.pm * BM + wr * 64 + fr, col0 = u.pn * BM + wc * 32 + 8 * fq;
        f32x4 rf[3][2][2]; u32x4 rh[3][2];
#define PG8_RLOAD(i) do { const size_t off_ = (size_t)(row0 + ((i) >> 2) * HALF + ((i) & 3) * 16) * 1024 + col0; _Pragma("unroll") for (int bj = 0; bj < 2; ++bj) { \
            if (RBF) rh[(i) % 3][bj] = *(const u32x4*)(Rb + off_ + bj * HALF); \
            else { rf[(i) % 3][bj][0] = *(const f32x4*)(R + off_ + bj * HALF); rf[(i) % 3][bj][1] = *(const f32x4*)(R + off_ + bj * HALF + 4); } } } while (0)
        PG8_RLOAD(0); PG8_RLOAD(1);
#pragma unroll
        for (int i = 0; i < 8; ++i) {
            const int ai = i >> 2, m = i & 3;
            if (i + 2 < 8) PG8_RLOAD(i + 2);
            asm volatile("" ::: "memory");
            const int row = row0 + ai * HALF + m * 16; const size_t off = (size_t)row * 1024 + col0; float q = 0.f;
#pragma unroll
            for (int bj = 0; bj < 2; ++bj) {
                f32x4 r0, r1;
                if (RBF) { const u32x4 h = rh[i % 3][bj];
                    r0 = (f32x4){__builtin_bit_cast(float, h.x << 16), __builtin_bit_cast(float, h.x & 0xffff0000u), __builtin_bit_cast(float, h.y << 16), __builtin_bit_cast(float, h.y & 0xffff0000u)};
                    r1 = (f32x4){__builtin_bit_cast(float, h.z << 16), __builtin_bit_cast(float, h.z & 0xffff0000u), __builtin_bit_cast(float, h.w << 16), __builtin_bit_cast(float, h.w & 0xffff0000u)}; }
                else { r0 = rf[i % 3][bj][0]; r1 = rf[i % 3][bj][1]; }
                const f32x4 o0 = r0 + acc[ai][bj][m][0] * alpha, o1 = r1 + acc[ai][bj][m][1] * alpha;
                if (OBF) {
                    u32x4 w; w.x = cvt_pk_bf16(o0[0], o0[1]); w.y = cvt_pk_bf16(o0[2], o0[3]); w.z = cvt_pk_bf16(o1[0], o1[1]); w.w = cvt_pk_bf16(o1[2], o1[3]);
                    *(u32x4*)(xb + off + bj * HALF) = w;
#pragma unroll
                    for (int e = 0; e < 4; ++e) { const float lo = __builtin_bit_cast(float, w[e] << 16), hi = __builtin_bit_cast(float, w[e] & 0xffff0000u); q += lo * lo + hi * hi; }
                } else { __builtin_nontemporal_store(o0, (f32x4*)(out + off + bj * HALF)); __builtin_nontemporal_store(o1, (f32x4*)(out + off + bj * HALF + 4)); }
            }
            if (OBF) { q += __shfl_xor(q, 16); q += __shfl_xor(q, 32); if (fq == 0) P[(ai * HALF + wr * 64 + m * 16 + fr) * 4 + wc] = q; }
            asm volatile("" ::: "memory");
        }
#undef PG8_RLOAD
    }
};

template <class Epi, class Sched, bool ALIGN_EPI = false, bool SP2 = false>
__device__ __forceinline__ void gemm_phase(PG8_LAS unsigned char* lds, const Gemm g, const Sched& S, const Epi& E) {
    const int tid = threadIdx.x, wid = __builtin_amdgcn_readfirstlane(tid >> 6), lane = tid & 63, wr = wid >> 2, wc = wid & 3, fr = lane & 15, fq = lane >> 4;
    const int K = g.K, nt = K / BK, lda = g.lda ? g.lda : g.K;
    unsigned voffA[2], voffB[2];
#pragma unroll
    for (int i = 0; i < 2; ++i) { int R, C; stage_rc(tid * 16 + i * 8192, R, C); const int Rb = Epi::PERM ? ((R & ~31) + perm32(R & 31)) : R;
        voffA[i] = (unsigned)(R * lda + C) * 2u; voffB[i] = (unsigned)(Rb * K + C) * 2u; }
    const size_t kstep = (size_t)(BK * 2);
    const size_t hstep = (size_t)HALF * K * 2, hstepA = (size_t)HALF * lda * 2;
    const size_t tstep = 2 * hstep, tstepA = 2 * hstepA;
    const unsigned ldsw = (unsigned)wid * 1024u;
    const int aoff = lds_byte(wr * 64 + fr, fq * 8), boff = lds_byte(wc * 32 + fr, fq * 8);
#define PG8_SA(b, h) (((b) * 2 + (h)) * HTB)
#define PG8_SB(b, h) ((4 + (b) * 2 + (h)) * HTB)
#define PG8_STAGE(bufoff, gbase, voff) do { _Pragma("unroll") for (int _i = 0; _i < 2; ++_i) \
        __builtin_amdgcn_global_load_lds((const unsigned*)((const char*)(gbase) + (voff)[_i]), (PG8_LAS unsigned*)(lds + (bufoff) + ldsw + _i * 8192), 16, 0, 0); } while (0)
#define PG8_LDA(dst, b, h) do { _Pragma("unroll") for (int m = 0; m < 4; ++m) _Pragma("unroll") for (int k = 0; k < 2; ++k) dst[m][k] = *(const PG8_LAS bf16x8*)(lds + PG8_SA(b, h) + aoff + m * 2048 + k * 1024); } while (0)
#define PG8_LDB(dst, b, h) do { _Pragma("unroll") for (int n = 0; n < 2; ++n) _Pragma("unroll") for (int k = 0; k < 2; ++k) dst[n][k] = *(const PG8_LAS bf16x8*)(lds + PG8_SB(b, h) + boff + n * 2048 + k * 1024); } while (0)
#define PG8_MMA(ai, bj, At, Bt) do { __builtin_amdgcn_s_setprio(1); _Pragma("unroll") for (int m = 0; m < 4; ++m) _Pragma("unroll") for (int n = 0; n < 2; ++n) _Pragma("unroll") for (int k = 0; k < 2; ++k) \
        acc[ai][bj][m][n] = __builtin_amdgcn_mfma_f32_16x16x32_bf16(Bt[n][k], At[m][k], acc[ai][bj][m][n], 0, 0, 0); __builtin_amdgcn_s_setprio(0); } while (0)
#define PG8_WAIT_V(n) asm volatile("s_waitcnt vmcnt(" #n ")" ::: "memory")
#define PG8_WAIT_L(n) asm volatile("s_waitcnt lgkmcnt(" #n ")" ::: "memory")
#define PG8_BAR __builtin_amdgcn_s_barrier()
#define PG8_SCHED __builtin_amdgcn_sched_barrier(0)
    Unit cur, nxt; int ui = 0;
    if (!S.next(0, cur)) return;
    f32x4 acc[2][2][4][2];
#pragma unroll
    for (int a = 0; a < 2; ++a)
#pragma unroll
        for (int b = 0; b < 2; ++b)
#pragma unroll
            for (int m = 0; m < 4; ++m)
#pragma unroll
                for (int n = 0; n < 2; ++n) acc[a][b][m][n] = (f32x4){0.f, 0.f, 0.f, 0.f};
    bf16x8 At[4][2], B0[2][2], B1[2][2];
    typename Epi::Pre pre;
    const char* cA = (const char*)g.A + (size_t)cur.pm * tstepA; const char* cB = (const char*)g.Bt + (size_t)cur.pn * tstep;
    S.a_ready(cur);
    if constexpr (SP2) {
        PG8_STAGE(PG8_SB(0, 0), cB, voffB); PG8_STAGE(PG8_SB(0, 1), cB + hstep, voffB); PG8_STAGE(PG8_SA(0, 0), cA, voffA); PG8_STAGE(PG8_SA(0, 1), cA + hstepA, voffA);
        if (wr == 1) PG8_BAR;
        PG8_WAIT_V(2); PG8_BAR;
        PG8_STAGE(PG8_SB(1, 0), cB + kstep, voffB); PG8_STAGE(PG8_SA(1, 0), cA + kstep, voffA); PG8_STAGE(PG8_SB(1, 1), cB + hstep + kstep, voffB);
        PG8_WAIT_V(6); PG8_BAR;
    } else {
        PG8_STAGE(PG8_SB(0, 0), cB, voffB); PG8_STAGE(PG8_SA(0, 0), cA, voffA); PG8_STAGE(PG8_SB(0, 1), cB + hstep, voffB); PG8_STAGE(PG8_SA(0, 1), cA + hstepA, voffA);
        if (wr == 1) PG8_BAR;
        PG8_WAIT_V(4); PG8_BAR;
        PG8_STAGE(PG8_SB(1, 0), cB + kstep, voffB); PG8_STAGE(PG8_SA(1, 0), cA + kstep, voffA); PG8_STAGE(PG8_SB(1, 1), cB + hstep + kstep, voffB);
        PG8_WAIT_V(6); PG8_BAR;
    }
    for (;;) {
        const bool has_next = S.next(ui + 1, nxt);
        const char* nA = has_next ? (const char*)g.A + (size_t)nxt.pm * tstepA : cA; const char* nB = has_next ? (const char*)g.Bt + (size_t)nxt.pn * tstep : cB;
        for (int t = 0; t < nt; t += 2) {
            const bool last = (t == nt - 2);
            const char* a1 = cA + (size_t)(t + 1) * kstep;
            const char* a2 = last ? nA : cA + (size_t)(t + 2) * kstep; const char* b2 = last ? nB : cB + (size_t)(t + 2) * kstep;
            const char* a3 = a2 + kstep; const char* b3 = b2 + kstep;
            if (last && has_next) S.a_ready(nxt);
            if (last) E.prefetch(pre, cur, wr, lane);
            if constexpr (SP2) {
            PG8_LDB(B0, 0, 0); PG8_LDB(B1, 0, 1); PG8_SCHED; PG8_LDA(At, 0, 0); PG8_STAGE(PG8_SA(1, 1), a1 + hstepA, voffA);
            PG8_WAIT_V(8); PG8_WAIT_L(0); PG8_BAR; PG8_MMA(0, 0, At, B0); PG8_MMA(0, 1, At, B1); PG8_BAR; PG8_SCHED;
            PG8_LDA(At, 0, 1); PG8_STAGE(PG8_SB(0, 0), b2, voffB); PG8_STAGE(PG8_SB(0, 1), b2 + hstep, voffB); PG8_STAGE(PG8_SA(0, 0), a2, voffA);
            PG8_WAIT_V(8); PG8_WAIT_L(0); PG8_BAR; PG8_MMA(1, 0, At, B0); PG8_MMA(1, 1, At, B1); PG8_BAR; PG8_SCHED;
            PG8_LDB(B0, 1, 0); PG8_LDB(B1, 1, 1); PG8_SCHED; PG8_LDA(At, 1, 0); PG8_STAGE(PG8_SA(0, 1), a2 + hstepA, voffA);
            PG8_WAIT_V(8); PG8_WAIT_L(0); PG8_BAR; PG8_MMA(0, 0, At, B0); PG8_MMA(0, 1, At, B1); PG8_BAR; PG8_SCHED;
            PG8_LDA(At, 1, 1); PG8_STAGE(PG8_SB(1, 0), b3, voffB); PG8_STAGE(PG8_SB(1, 1), b3 + hstep, voffB); PG8_STAGE(PG8_SA(1, 0), a3, voffA);
            PG8_WAIT_V(8); PG8_WAIT_L(0); PG8_BAR; PG8_MMA(1, 0, At, B0); PG8_MMA(1, 1, At, B1); PG8_BAR; PG8_SCHED;
            } else {
            PG8_LDB(B0, 0, 0); PG8_SCHED; PG8_LDA(At, 0, 0); PG8_STAGE(PG8_SA(1, 1), a1 + hstepA, voffA);
            PG8_WAIT_L(8); PG8_BAR; PG8_WAIT_L(0); PG8_MMA(0, 0, At, B0); PG8_BAR; PG8_SCHED;
            PG8_LDB(B1, 0, 1); PG8_STAGE(PG8_SB(0, 0), b2, voffB);
            PG8_BAR; PG8_WAIT_L(0); PG8_MMA(0, 1, At, B1); PG8_BAR;
            PG8_LDA(At, 0, 1); PG8_STAGE(PG8_SA(0, 0), a2, voffA);
            PG8_BAR; PG8_WAIT_L(0); PG8_MMA(1, 0, At, B0); PG8_BAR; PG8_SCHED;
            PG8_STAGE(PG8_SB(0, 1), b2 + hstep, voffB);
            PG8_WAIT_V(6); PG8_BAR; PG8_MMA(1, 1, At, B1); PG8_BAR;
            PG8_LDB(B0, 1, 0); PG8_SCHED; PG8_LDA(At, 1, 0); PG8_STAGE(PG8_SA(0, 1), a2 + hstepA, voffA);
            PG8_WAIT_L(8); PG8_BAR; PG8_WAIT_L(0); PG8_MMA(0, 0, At, B0); PG8_BAR; PG8_SCHED;
            PG8_LDB(B1, 1, 1); PG8_STAGE(PG8_SB(1, 0), b3, voffB);
            PG8_BAR; PG8_WAIT_L(0); PG8_MMA(0, 1, At, B1); PG8_BAR;
            PG8_LDA(At, 1, 1); PG8_STAGE(PG8_SA(1, 0), a3, voffA);
            PG8_BAR; PG8_WAIT_L(0); PG8_MMA(1, 0, At, B0); PG8_BAR; PG8_SCHED;
            PG8_STAGE(PG8_SB(1, 1), b3 + hstep, voffB);
            PG8_WAIT_V(6); PG8_BAR; PG8_MMA(1, 1, At, B1); PG8_BAR;
            }
        }
        if constexpr (ALIGN_EPI) { if (wr == 0) PG8_BAR; }
        if constexpr (!Epi::AFTER_DRAIN) { E(acc, pre, cur, wr, wc, fr, fq); S.done(cur); }
        if (!has_next) break;
#pragma unroll
        for (int a = 0; a < 2; ++a)
#pragma unroll
            for (int b = 0; b < 2; ++b)
#pragma unroll
                for (int m = 0; m < 4; ++m)
#pragma unroll
                    for (int n = 0; n < 2; ++n) acc[a][b][m][n] = (f32x4){0.f, 0.f, 0.f, 0.f};
        cur = nxt; cA = nA; cB = nB; ++ui;
        if constexpr (ALIGN_EPI) { if (wr == 1) PG8_BAR; }
    }
    PG8_WAIT_V(0);
    if constexpr (!ALIGN_EPI) { if (wr == 0) PG8_BAR; }
    PG8_BAR;
    if constexpr (Epi::AFTER_DRAIN) { E.fused(acc, cur, wr, wc, fr, fq, lds, wid, lane); S.done(cur); asm volatile("s_waitcnt lgkmcnt(0)" ::: "memory"); PG8_BAR; }
#undef PG8_SA
#undef PG8_SB
#undef PG8_STAGE
#undef PG8_LDA
#undef PG8_LDB
#undef PG8_MMA
#undef PG8_WAIT_V
#undef PG8_WAIT_L
#undef PG8_BAR
#undef PG8_SCHED
}
}

#ifndef PG8_SP2
#define PG8_SP2 true
#endif
#ifndef PG8_ALIGN
#define PG8_ALIGN true
#endif

constexpr int NWAVES = 8;
constexpr int N_LAUNCHES = 1;
constexpr int PER_PHASE = 8;
constexpr int M = 16384, D = 1024, FF = 2816, DIN = 1280, SEQ = 2048;
constexpr int NGU = 2 * FF;
constexpr float LOG2E = 1.4426950408889634f;
constexpr float QSCALE = 0.125f * LOG2E;

constexpr size_t MiB = 1u << 20;
constexpr size_t WS_CTL = 0, CTL_ZERO_BYTES = 53248;
constexpr size_t WS_W1GU = 2 * MiB;
constexpr size_t WS_W1D = 14 * MiB;
constexpr size_t WS_WIN = 20 * MiB;
constexpr size_t WS_WOUT = 23 * MiB;
constexpr size_t WS_W2GU = 26 * MiB;
constexpr size_t WS_W2D = 38 * MiB;
constexpr size_t WS_WPOOL = 44 * MiB;
constexpr size_t WS_SS0 = 45 * MiB, WS_SS1 = 46 * MiB, WS_SS2 = 47 * MiB;
constexpr size_t WS_XB = 48 * MiB;
constexpr size_t WS_H = 80 * MiB;
constexpr size_t WS_END = 168 * MiB;
static_assert(WS_H + (size_t)M * FF * 2 <= WS_END && (D + DIN) <= FF, "d_ws map");
constexpr int CW_BAR = 4096;

constexpr int RING_OFF = 0, RING_BYTES = 131072;
constexpr int LDSCTL_OFF = RING_BYTES, MISC_OFF = LDSCTL_OFF + 320;
constexpr int LDS_BYTES = 147456;

#define GAS __attribute__((address_space(1)))
#define LAS __attribute__((address_space(3)))
typedef unsigned short bf16;
typedef unsigned v4u __attribute__((ext_vector_type(4)));
typedef unsigned v2u __attribute__((ext_vector_type(2)));
typedef float f32x4 __attribute__((ext_vector_type(4)));
typedef float f32x16 __attribute__((ext_vector_type(16)));
typedef short bf16x8 __attribute__((ext_vector_type(8)));
typedef short s16x4 __attribute__((ext_vector_type(4)));
typedef GAS unsigned gu32;
#define RLX_AGENT __ATOMIC_RELAXED, __HIP_MEMORY_SCOPE_AGENT
#define LDS_WAIT() asm volatile("s_waitcnt lgkmcnt(0)" ::: "memory")
#define VM_WAIT() asm volatile("s_waitcnt vmcnt(0)" ::: "memory")
__device__ __forceinline__ unsigned f2bf(float f) { unsigned u = __builtin_bit_cast(unsigned, f); return (u + 0x7fffu + ((u >> 16) & 1u)) >> 16; }
__device__ __forceinline__ unsigned pk2(float lo, float hi) { return f2bf(lo) | (f2bf(hi) << 16); }
__device__ __forceinline__ float bf2f(unsigned short b) { return __builtin_bit_cast(float, (unsigned)b << 16); }

#define XB_TMO      128
#define XB_XCNT(j)  (256  + 64 * (j))
#define XB_XSUB(j)  (1280 + 64 * (j))
#define XB_XGEN(j)  (2304 + 64 * (j))
#define XB_TOP      3328
#define XB_TOPGEN   3392
#define XCD_BAR_WORDS 3456
#define XB_PNL(p)   (4544 + 64 * (p))
#define XB_W1       (4544 + 64 * 64)
#define XB_CONV     (3456 + 64 * 16)
#define XB_LOC(j)   (3456 + 64 * (j))
#define XB_SPIN_CAP (1u << 18)
__device__ __forceinline__ unsigned xb_ld(unsigned* p)              { return __hip_atomic_load(p, __ATOMIC_RELAXED, __HIP_MEMORY_SCOPE_AGENT); }
__device__ __forceinline__ unsigned xb_add(unsigned* p, unsigned v) { return __hip_atomic_fetch_add(p, v, __ATOMIC_RELAXED, __HIP_MEMORY_SCOPE_AGENT); }
__device__ __forceinline__ unsigned xb_xcc_id() { return (unsigned)__builtin_amdgcn_s_getreg((3 << 11) | 20) & 0xFu; }
#define XB_SPIN(cond, bar) do { unsigned _sp = 0; while (cond) { __builtin_amdgcn_s_sleep(1); \
    if ((++_sp & 255u) == 0u) { if (xb_ld(&(bar)[XB_TMO])) break; if (_sp > XB_SPIN_CAP) { atomicAdd(&(bar)[XB_TMO], 1u); break; } } } } while (0)
struct XcdBarrier { unsigned* bar; unsigned x; volatile LAS unsigned* st; };
__device__ __forceinline__ XcdBarrier xcd_barrier_post(unsigned* bar, volatile LAS unsigned* st) {
    XcdBarrier b; b.bar = bar; b.x = xb_xcc_id(); b.st = st;
    if (threadIdx.x == 0) st[2] = xb_add(&bar[XB_XCNT(b.x)], 1u);
    return b;
}
__device__ __forceinline__ void xcd_barrier_complete(unsigned* bar, unsigned x, unsigned& nloc, unsigned& nx) {
    const unsigned G = gridDim.x * gridDim.y * gridDim.z;
    unsigned sum, cnt, mine, sp = 0u;
    for (;;) {
        sum = 0u; cnt = 0u; mine = 0u;
#pragma unroll
        for (unsigned j = 0; j < 16; ++j) { const unsigned c = xb_ld(&bar[XB_XCNT(j)]); sum += c; cnt += (c > 0u) ? 1u : 0u; mine = (j == x) ? c : mine; }
        if (sum == G) break;
        __builtin_amdgcn_s_sleep(1);
        if ((++sp & 255u) == 0u) { if (xb_ld(&bar[XB_TMO])) break; if (sp > XB_SPIN_CAP) { atomicAdd(&bar[XB_TMO], 1u); break; } }
    }
    nloc = mine > 0u ? mine : 1u; nx = cnt > 0u ? cnt : 1u;
}
__device__ __forceinline__ bool xcd_topology_regular(unsigned* bar) {
    bool ok = true;
#pragma unroll
    for (unsigned j = 0; j < 16; ++j) { const unsigned c = xb_ld(&bar[XB_XCNT(j)]); ok = ok && (c == (j < 8u ? 32u : 0u)); }
    return ok;
}
__device__ __forceinline__ void xcd_barrier(const XcdBarrier& b) {
    asm volatile("s_waitcnt vmcnt(0)" ::: "memory");
    __syncthreads();
    if (threadIdx.x == 0) {
        unsigned* bar = b.bar;
        __builtin_amdgcn_s_waitcnt(0);
        unsigned nloc = b.st[0], nx = b.st[1];
        if (nloc == 0u) { xcd_barrier_complete(bar, b.x, nloc, nx); b.st[0] = nloc; b.st[1] = nx; b.st[3] = xcd_topology_regular(bar) ? 1u : 2u; }
        const unsigned old = xb_add(&bar[XB_XSUB(b.x)], 1u);
        const unsigned gen = old / nloc;
        if (old + 1u == (gen + 1u) * nloc) {
            __builtin_amdgcn_fence(__ATOMIC_RELEASE, "agent");
            asm volatile("s_waitcnt vmcnt(0)" ::: "memory");
            const unsigned og = xb_add(&bar[XB_TOP], 1u);
            const unsigned tg = og / nx;
            if (og + 1u == (tg + 1u) * nx) xb_add(&bar[XB_TOPGEN], 1u);
            else XB_SPIN(xb_ld(&bar[XB_TOPGEN]) == tg, bar);
            __builtin_amdgcn_fence(__ATOMIC_ACQUIRE, "agent");
            xb_add(&bar[XB_XGEN(b.x)], 1u);
            asm volatile("s_waitcnt vmcnt(0)" ::: "memory");
        } else {
            XB_SPIN(xb_ld(&bar[XB_XGEN(b.x)]) == gen, bar);
            __builtin_amdgcn_fence(__ATOMIC_ACQUIRE, "agent");
            asm volatile("s_waitcnt vmcnt(0)" ::: "memory");
        }
    }
    __syncthreads();
}

__device__ __forceinline__ void xcd_local_barrier(const XcdBarrier& b, unsigned& lgen, unsigned* extra = nullptr, unsigned extra_target = 0u) {
    asm volatile("s_waitcnt vmcnt(0)" ::: "memory");
    __syncthreads();
    if (threadIdx.x == 0) {
        __builtin_amdgcn_s_waitcnt(0);
        unsigned* w = &b.bar[XB_LOC(b.x)];
        (void)xb_add(w, 1u);
        const unsigned target = (lgen + 1u) * 32u;
        XB_SPIN(xb_ld(w) < target, b.bar);
        if (extra) XB_SPIN(xb_ld(extra) < extra_target, b.bar);
        __builtin_amdgcn_fence(__ATOMIC_ACQUIRE, "agent");
        asm volatile("s_waitcnt vmcnt(0)" ::: "memory");
    }
    ++lgen;
    __syncthreads();
}

__device__ __forceinline__ void xcd_panel_barrier(const XcdBarrier& b, unsigned& pgen, int pm, unsigned* extra = nullptr, unsigned extra_target = 0u) {
    asm volatile("s_waitcnt vmcnt(0)" ::: "memory");
    __syncthreads();
    if (threadIdx.x == 0) {
        __builtin_amdgcn_s_waitcnt(0);
        unsigned* w = &b.bar[XB_PNL(pm)];
        (void)xb_add(w, 1u);
        const unsigned target = (pgen + 1u) * 4u;
        XB_SPIN(xb_ld(w) < target, b.bar);
        if (extra) XB_SPIN(xb_ld(extra) < extra_target, b.bar);
        __builtin_amdgcn_fence(__ATOMIC_ACQUIRE, "agent");
        asm volatile("s_waitcnt vmcnt(0)" ::: "memory");
    }
    ++pgen;
    __syncthreads();
}

struct Frame {
    LAS unsigned char* lds;
    volatile LAS unsigned* MISC;
    gu32* ctl;
    int tid, lane, wave;
    int vcu, G;
};
__device__ __forceinline__ float wave_sum(float v) {
#pragma unroll
    for (int o = 1; o < 64; o <<= 1) v += __shfl_xor(v, o);
    return v;
}

__device__ __forceinline__ int dest_row(int mode, int n0) {
    if (mode == 0) return n0;
    if (mode == 1) return 256 * (n0 >> 7) + (n0 & 127);
    if (mode == 2) return 256 * (n0 >> 7) + 128 + (n0 & 127);
    return 256 * (n0 >> 8) + 128 * ((n0 >> 5) & 1) + 32 * ((n0 >> 6) & 3);
}
template <bool WTH = false>
__device__ __forceinline__ void p0_transpose_item(const float* W, int K, int N, bf16* WT, int mode, const float* gain, LAS float* scr, int item, int lane) {
    const int nblk = N / 32, kb = item / nblk, nb = item % nblk, k0 = 64 * kb, n0 = 32 * nb;
    { f32x4 t[8];
#pragma unroll
      for (int i = 0; i < 8; ++i) t[i] = __builtin_nontemporal_load((const f32x4*)(W + (size_t)(k0 + 8 * i + (lane >> 3)) * N + n0 + 4 * (lane & 7)));
#pragma unroll
      for (int i = 0; i < 8; ++i) { LAS float* d = scr + (8 * i + (lane >> 3)) * 33 + 4 * (lane & 7); d[0] = t[i][0]; d[1] = t[i][1]; d[2] = t[i][2]; d[3] = t[i][3]; } }
    LDS_WAIT(); asm volatile("" ::: "memory");
    const int c = lane & 7;
    f32x4 ga = (f32x4){1.f, 1.f, 1.f, 1.f}, gb = ga;
    if (gain) { ga = *(const f32x4*)(gain + k0 + 8 * c); gb = *(const f32x4*)(gain + k0 + 8 * c + 4); }
    const int r0 = dest_row(mode, n0);
    const __amdgpu_buffer_rsrc_t wtr = WT_RSRC(WT);
#pragma unroll
    for (int j = 0; j < 4; ++j) { const int n = (lane >> 3) + 8 * j; const LAS float* s = scr + (8 * c) * 33 + n;
        v4u o; o.x = pk2(s[0 * 33] * ga[0], s[1 * 33] * ga[1]); o.y = pk2(s[2 * 33] * ga[2], s[3 * 33] * ga[3]); o.z = pk2(s[4 * 33] * gb[0], s[5 * 33] * gb[1]); o.w = pk2(s[6 * 33] * gb[2], s[7 * 33] * gb[3]);
        if (WTH) WT_ST16(wtr, ((size_t)(r0 + n) * K + k0 + 8 * c) * 2, o); else *(GAS v4u*)(WT + (size_t)(r0 + n) * K + k0 + 8 * c) = o; }
    LDS_WAIT(); asm volatile("" ::: "memory");
}

namespace mixp {
__device__ const unsigned char kBucket[128] = {0,1,2,3,4,5,6,7,8,9,10,11,12,13,14,15,16,16,16,17,17,18,18,18,19,19,19,20,20,20,20,21,21,21,21,22,22,22,22,22,23,23,23,23,23,23,24,24,24,24,24,24,25,25,25,25,25,25,25,26,26,26,26,26,26,26,26,27,27,27,27,27,27,27,27,27,27,28,28,28,28,28,28,28,28,28,28,29,29,29,29,29,29,29,29,29,29,29,29,30,30,30,30,30,30,30,30,30,30,30,30,30,30,31,31,31,31,31,31,31,31,31,31,31,31,31,31,31};
constexpr int ZP = FF, YP = FF;
constexpr int L_K = 0, L_V = 32768, L_TB = 65536, L_U = 68608, L_PA = 0;
constexpr float NEG = -1e30f;
typedef short v4i16_t __attribute__((ext_vector_type(4)));
__device__ __forceinline__ s16x4 vtr(const LAS unsigned char* p) { return __builtin_bit_cast(s16x4, __builtin_amdgcn_ds_read_tr16_b64_v4i16((LAS v4i16_t*)p)); }
__device__ __forceinline__ unsigned cvtpk(float lo, float hi) { unsigned r; asm volatile("v_cvt_pk_bf16_f32 %0, %1, %2" : "=v"(r) : "v"(lo), "v"(hi)); return r; }

__device__ __forceinline__ int fsw(int r) { return (((r >> 1) & 1) << 2) | ((r >> 2) & 1) | (((r >> 3) & 1) << 1); }
__device__ __forceinline__ void store16_rows(bf16* rowp  , int h2, v2u g0, v2u g1, v2u g2, v2u g3) {
    { const auto rx = __builtin_amdgcn_permlane32_swap(g0.x, g1.x, false, false); const auto ry = __builtin_amdgcn_permlane32_swap(g0.y, g1.y, false, false);
      *(GAS v4u*)(rowp + 8 * h2) = (v4u){rx[0], ry[0], rx[1], ry[1]}; }
    { const auto rx = __builtin_amdgcn_permlane32_swap(g2.x, g3.x, false, false); const auto ry = __builtin_amdgcn_permlane32_swap(g2.y, g3.y, false, false);
      *(GAS v4u*)(rowp + 16 + 8 * h2) = (v4u){rx[0], ry[0], rx[1], ry[1]}; }
}
struct UTile { v4u x[5]; };
__device__ __forceinline__ void utile_load(UTile& U, const bf16* Z, int pu, int tid) {
    const int tile = pu >> 2, g = pu & 3, t0 = tile * 128, s0 = t0 % SEQ;
#pragma unroll
    for (int k = 0; k < 5; ++k) {
        const int chunk = tid + 512 * k, row = chunk >> 4, c = chunk & 15;
        const bool ok = (k < 4 || tid < 256) && (s0 > 0 || row >= 16);
        const int rr = ok ? row : 16;
        const v4u v = *(const GAS v4u*)(Z + (size_t)(t0 - 16 + rr) * ZP + 768 + g * 128 + 8 * c);
        U.x[k] = ok ? v : (v4u){0u, 0u, 0u, 0u};
    }
}
__device__ __forceinline__ void utile_store(const UTile& U, LAS unsigned char* lds, int tid) {
#pragma unroll
    for (int k = 0; k < 5; ++k) { const int chunk = tid + 512 * k; if (k < 4 || tid < 256) *(LAS v4u*)(lds + L_U + chunk * 16) = U.x[k]; }
}

__device__ __forceinline__ void attn_unit(LAS unsigned char* lds, const bf16* Z, bf16* Y, const float* sinks, const float* rel_bias, int unit, int pu0, int tid, int wid, int lane) {
    const int b = unit >> 5, blk = (unit >> 1) & 15, kv = unit & 1;
    const int tok0 = b * SEQ + blk * 128;
    const int g = wid >> 1, rh = wid & 1, h = kv * 4 + g;
    const int q32 = lane & 31, h2 = lane >> 5;
    v4u kk[4], vv[4];
#pragma unroll
    for (int i = 0; i < 4; ++i) {
        const int chunk = tid + 512 * i, row = chunk >> 3, c = chunk & 7;
        const int rr = (blk > 0 || row >= 128) ? row : 128;
        const bf16* src = Z + (size_t)(tok0 - 128 + rr) * ZP + 512 + kv * 64 + c * 8;
        kk[i] = *(const GAS v4u*)(src); vv[i] = *(const GAS v4u*)(src + 128);
    }
    bf16x8 qf[2][4];
#pragma unroll
    for (int jj = 0; jj < 2; ++jj) { const bf16* qp = Z + (size_t)(tok0 + 32 * (2 * rh + jj) + q32) * ZP + h * 64 + 8 * h2;
#pragma unroll
        for (int s = 0; s < 4; ++s) qf[jj][s] = *(const GAS bf16x8*)(qp + 16 * s); }
    UTile U; if (pu0 >= 0) utile_load(U, Z, pu0, tid);
    for (int i = tid; i < 768; i += 512) { const int gg = i / 192, dd = i % 192 - 32; const int dc = dd < 0 ? 0 : (dd > 127 ? 127 : dd); ((LAS float*)(lds + L_TB))[i] = (rel_bias[kBucket[dc] * 8 + kv * 4 + gg] - sinks[kv * 4 + gg]) * LOG2E; }
#pragma unroll
    for (int i = 0; i < 4; ++i) { const int chunk = tid + 512 * i, row = chunk >> 3, c = chunk & 7;
        const int sl = (c ^ fsw(row)) * 16; *(LAS v4u*)(lds + L_K + row * 128 + sl) = kk[i]; *(LAS v4u*)(lds + L_V + row * 128 + sl) = vv[i]; }
    if (pu0 >= 0) utile_store(U, lds, tid);
    LDS_WAIT(); __syncthreads();
    const LAS float* tb = (const LAS float*)(lds + L_TB) + g * 192 + 32 + q32 - 4 * h2;
    int koff[4];
#pragma unroll
    for (int sx = 0; sx < 4; ++sx) koff[sx] = q32 * 128 + (((2 * sx + h2) ^ fsw(q32)) * 16);
    int voff[2][2];
#pragma unroll
    for (int a = 0; a < 2; ++a)
#pragma unroll
        for (int dh = 0; dh < 2; ++dh) { const int vr = 8 * a + 4 * (lane >> 5) + ((lane & 15) >> 2), ch = 4 * dh + 2 * ((lane >> 4) & 1) + ((lane & 3) >> 1);
            voff[a][dh] = vr * 128 + ((ch ^ fsw(vr)) * 16) + 8 * (lane & 1); }
#pragma unroll
    for (int jj = 0; jj < 2; ++jj) {
        const int j = 2 * rh + jj;
        f32x16 S[5];
#pragma unroll
        for (int t = 0; t < 5; ++t) {
            const int kt = j + t;
            if (blk == 0 && kt < 4) {
#pragma unroll
                for (int r = 0; r < 16; ++r) S[t][r] = NEG;
            } else {
                f32x16 a = {};
#pragma unroll
                for (int s = 0; s < 4; ++s) { const bf16x8 kf = *(const LAS bf16x8*)(lds + L_K + 32 * kt * 128 + koff[s]); a = __builtin_amdgcn_mfma_f32_32x32x16_bf16(kf, qf[jj][s], a, 0, 0, 0); }
#pragma unroll
                for (int r = 0; r < 16; ++r) {
                    const int cofs = 128 - 32 * t - ((r & 3) + 8 * (r >> 2));
                    const float v = a[r] + tb[cofs];
                    if (t == 0) a[r] = (cofs + q32 - 4 * h2 <= 127) ? v : NEG;
                    else if (t == 4) a[r] = (cofs + q32 - 4 * h2 >= 0) ? v : NEG;
                    else a[r] = v;
                }
                S[t] = a;
            }
        }
        float lsum = 0.f;
#pragma unroll
        for (int t = 0; t < 5; ++t)
#pragma unroll
            for (int r = 0; r < 16; ++r) { const float p = __builtin_amdgcn_exp2f(S[t][r]); S[t][r] = p; lsum += p; }
        lsum += __shfl_xor(lsum, 32);
        lsum += 1.0f;
        f32x16 o0 = {}, o1 = {};
#pragma unroll
        for (int t = 0; t < 5; ++t) {
            const int kt = j + t;
            if (!(blk == 0 && kt < 4)) {
#pragma unroll
                for (int s = 0; s < 2; ++s) {
                    v4u pw; pw.x = cvtpk(S[t][8 * s + 0], S[t][8 * s + 1]); pw.y = cvtpk(S[t][8 * s + 2], S[t][8 * s + 3]); pw.z = cvtpk(S[t][8 * s + 4], S[t][8 * s + 5]); pw.w = cvtpk(S[t][8 * s + 6], S[t][8 * s + 7]);
                    const bf16x8 pf = __builtin_bit_cast(bf16x8, pw);
                    const LAS unsigned char* vb = lds + L_V + (32 * kt + 16 * s) * 128;
                    const s16x4 a0 = vtr(vb + voff[0][0]), a1 = vtr(vb + voff[1][0]), b0 = vtr(vb + voff[0][1]), b1 = vtr(vb + voff[1][1]);
                    const bf16x8 v0 = (bf16x8){a0[0], a0[1], a0[2], a0[3], a1[0], a1[1], a1[2], a1[3]};
                    const bf16x8 v1 = (bf16x8){b0[0], b0[1], b0[2], b0[3], b1[0], b1[1], b1[2], b1[3]};
                    o0 = __builtin_amdgcn_mfma_f32_32x32x16_bf16(v0, pf, o0, 0, 0, 0);
                    o1 = __builtin_amdgcn_mfma_f32_32x32x16_bf16(v1, pf, o1, 0, 0, 0);
                }
            }
        }
        const float rl = 1.0f / lsum;
        bf16* yp = Y + (size_t)(tok0 + 32 * j + q32) * YP + h * 64;
        v2u w0[4], w1[4];
#pragma unroll
        for (int rg = 0; rg < 4; ++rg) {
            w0[rg].x = cvtpk(o0[4 * rg + 0] * rl, o0[4 * rg + 1] * rl); w0[rg].y = cvtpk(o0[4 * rg + 2] * rl, o0[4 * rg + 3] * rl);
            w1[rg].x = cvtpk(o1[4 * rg + 0] * rl, o1[4 * rg + 1] * rl); w1[rg].y = cvtpk(o1[4 * rg + 2] * rl, o1[4 * rg + 3] * rl);
        }
        store16_rows(yp, h2, w0[0], w0[1], w0[2], w0[3]); store16_rows(yp + 32, h2, w1[0], w1[1], w1[2], w1[3]);
    }
    LDS_WAIT(); __syncthreads();
}

__device__ __forceinline__ void pool_stage(LAS unsigned char* lds, const bf16* Z, int pu, int tid) { UTile U; utile_load(U, Z, pu, tid); utile_store(U, lds, tid); LDS_WAIT(); __syncthreads(); }
__device__ __forceinline__ void pool_unit(LAS unsigned char* lds, const bf16* Z, bf16* Y, const bf16* WpT, const float* pscale, int pu, int pu_next, int tid, int wid, int lane) {
    const int tile = pu >> 2, g = pu & 3, t0 = tile * 128, s0 = t0 % SEQ, w = 2 << g;
    const int wr4 = wid >> 1, wcn = wid & 1, q32 = lane & 31, h2 = lane >> 5;
    bf16x8 wf[2][8];
    { const bf16* wp = WpT + (size_t)g * 128 * 128 + (size_t)(64 * wcn + q32) * 128 + 8 * h2;
#pragma unroll
      for (int s = 0; s < 8; ++s) { wf[0][s] = *(const GAS bf16x8*)(wp + 16 * s); wf[1][s] = *(const GAS bf16x8*)(wp + 32 * 128 + 16 * s); } }
    {
        const int cv = tid & 15, seg = tid >> 4;
        const LAS unsigned char* ub = lds + L_U + (16 + 4 * seg) * 256 + cv * 16;
        float sum[8];
#pragma unroll
        for (int e = 0; e < 8; ++e) sum[e] = 0.f;
        for (int jx = 0; jx < w; ++jx) {
            const v4u x = *(const LAS v4u*)(ub - jx * 256);
#pragma unroll
            for (int e = 0; e < 4; ++e) { sum[2 * e] += bf2f((unsigned short)(x[e] & 0xffffu)); sum[2 * e + 1] += bf2f((unsigned short)(x[e] >> 16)); }
        }
#pragma unroll
        for (int i = 0; i < 4; ++i) {
            const int tt = 4 * seg + i;
            const v4u xc = *(const LAS v4u*)(ub + i * 256);
            float cur[8];
#pragma unroll
            for (int e = 0; e < 4; ++e) { cur[2 * e] = bf2f((unsigned short)(xc[e] & 0xffffu)); cur[2 * e + 1] = bf2f((unsigned short)(xc[e] >> 16)); }
            if (i > 0) {
                const v4u xo = *(const LAS v4u*)(ub + (i - w) * 256);
#pragma unroll
                for (int e = 0; e < 4; ++e) { sum[2 * e] += cur[2 * e] - bf2f((unsigned short)(xo[e] & 0xffffu)); sum[2 * e + 1] += cur[2 * e + 1] - bf2f((unsigned short)(xo[e] >> 16)); }
            }
            const int cn = (s0 + tt + 1) < w ? (s0 + tt + 1) : w; const float ic = 1.0f / (float)cn;
            v4u o;
            o.x = cvtpk(sum[0] * ic - cur[0], sum[1] * ic - cur[1]); o.y = cvtpk(sum[2] * ic - cur[2], sum[3] * ic - cur[3]);
            o.z = cvtpk(sum[4] * ic - cur[4], sum[5] * ic - cur[5]); o.w = cvtpk(sum[6] * ic - cur[6], sum[7] * ic - cur[7]);
            *(LAS v4u*)(lds + L_PA + tt * 256 + ((cv ^ (tt & 15)) * 16)) = o;
        }
    }
    LDS_WAIT(); __syncthreads();
    UTile U; if (pu_next >= 0) utile_load(U, Z, pu_next, tid);
    {
        f32x16 acc0 = {}, acc1 = {};
        const int prow = 32 * wr4 + q32;
#pragma unroll
        for (int s = 0; s < 8; ++s) {
            const bf16x8 pf = *(const LAS bf16x8*)(lds + L_PA + prow * 256 + (((2 * s + h2) ^ (prow & 15)) * 16));
            acc0 = __builtin_amdgcn_mfma_f32_32x32x16_bf16(wf[0][s], pf, acc0, 0, 0, 0);
            acc1 = __builtin_amdgcn_mfma_f32_32x32x16_bf16(wf[1][s], pf, acc1, 0, 0, 0);
        }
        bf16* yp = Y + (size_t)(t0 + prow) * YP + 512 + g * 128 + 64 * wcn;
        const float* sp = pscale + g * 128 + 64 * wcn + 4 * h2;
        v2u a[4], c[4];
#pragma unroll
        for (int rg = 0; rg < 4; ++rg) {
            const f32x4 s0v = *(const f32x4*)(sp + 8 * rg), s1v = *(const f32x4*)(sp + 32 + 8 * rg);
            a[rg].x = cvtpk(acc0[4 * rg + 0] * s0v[0], acc0[4 * rg + 1] * s0v[1]); a[rg].y = cvtpk(acc0[4 * rg + 2] * s0v[2], acc0[4 * rg + 3] * s0v[3]);
            c[rg].x = cvtpk(acc1[4 * rg + 0] * s1v[0], acc1[4 * rg + 1] * s1v[1]); c[rg].y = cvtpk(acc1[4 * rg + 2] * s1v[2], acc1[4 * rg + 3] * s1v[3]);
        }
        store16_rows(yp, h2, a[0], a[1], a[2], a[3]); store16_rows(yp + 32, h2, c[0], c[1], c[2], c[3]);
    }
    if (pu_next >= 0) utile_store(U, lds, tid);
    LDS_WAIT(); __syncthreads();
}
}

struct Args { const float* in[18]; float* out; unsigned char* ws; int ph_lo, ph_hi, li, pad; };
__global__ void __launch_bounds__(NWAVES * 64, 2) mega_fwd(Args args) {
    extern __shared__ __attribute__((aligned(16))) unsigned char lds[];
    Frame F;
    F.lds = (LAS unsigned char*)lds;
    F.MISC = (volatile LAS unsigned*)(F.lds + MISC_OFF);
    F.tid = threadIdx.x; F.lane = F.tid & 63; F.wave = __builtin_amdgcn_readfirstlane(F.tid >> 6);
    F.G = gridDim.x; { const int bx = blockIdx.x; F.vcu = (F.G % 8 == 0) ? (bx % 8) * (F.G / 8) + bx / 8 : bx; }
    unsigned char* ws = args.ws;
    F.ctl = (gu32*)(ws + WS_CTL);
    const float* x = args.in[0];
    const float *ffn1_norm = args.in[1], *ffn1_wg = args.in[2], *ffn1_wu = args.in[3], *ffn1_wd = args.in[4], *mix_norm = args.in[5], *w_in = args.in[6], *q_norm = args.in[7], *k_norm = args.in[8];
    const float *sinks = args.in[9], *rel_bias = args.in[10], *pool_w = args.in[11], *pool_scale = args.in[12], *w_out = args.in[13], *ffn2_norm = args.in[14], *ffn2_wg = args.in[15], *ffn2_wu = args.in[16], *ffn2_wd = args.in[17];
    float* out = args.out;
    bf16 *W1GU = (bf16*)(ws + WS_W1GU), *W1D = (bf16*)(ws + WS_W1D), *WIN = (bf16*)(ws + WS_WIN), *WOUT = (bf16*)(ws + WS_WOUT), *W2GU = (bf16*)(ws + WS_W2GU), *W2D = (bf16*)(ws + WS_W2D), *WPOOL = (bf16*)(ws + WS_WPOOL);
    float *SS0 = (float*)(ws + WS_SS0), *SS1 = (float*)(ws + WS_SS1), *SS2 = (float*)(ws + WS_SS2);
    bf16 *XB = (bf16*)(ws + WS_XB), *HB = (bf16*)(ws + WS_H), *YB = (bf16*)(ws + WS_H), *ZB = (bf16*)(ws + WS_H) + D;

    for (int u = F.tid; u < (LDS_BYTES - LDSCTL_OFF) / 4; u += NWAVES * 64) ((LAS unsigned*)(F.lds + LDSCTL_OFF))[u] = 0u;
    __syncthreads();
    const int bli = (N_LAUNCHES == PER_PHASE) ? 0 : args.li;
    XcdBarrier bar; bar.bar = (unsigned*)(F.ctl + CW_BAR) + bli * XCD_BAR_WORDS; bar.x = 0; bar.st = nullptr;
    if (N_LAUNCHES != PER_PHASE) bar = xcd_barrier_post((unsigned*)(F.ctl + CW_BAR) + bli * XCD_BAR_WORDS, F.MISC + 8);
#define GRID_BAR() do { if (N_LAUNCHES != PER_PHASE) xcd_barrier(bar); } while (0)
    unsigned lgen = 0u; bool topo = false; int cid = (int)blockIdx.x;
    unsigned pgen = 0u;
#define LOCAL_BAR() do { if (topo) xcd_local_barrier(bar, lgen); else xcd_barrier(bar); } while (0)
#define PANEL_BAR() do { if (topo) xcd_panel_barrier(bar, pgen, 8 * (cid & 7) + ((cid >> 3) & 7)); else xcd_barrier(bar); } while (0)
    const int lo = args.ph_lo, hi = args.ph_hi;
#define IN(k) (lo <= (k) && (k) < hi)
#define BOTH(k) (IN(k) && IN((k) + 1))

    if (IN(0)) { for (int rep_ = 0; rep_ < NREP(0); ++rep_) {
        LAS float* scr = (LAS float*)(F.lds + RING_OFF + F.wave * 16384);
        const int gw = F.vcu * NWAVES + F.wave, NGW = F.G * NWAVES;
        constexpr int I_GU = (D / 64) * (FF / 32);
        for (int it = gw; it < 2 * I_GU; it += NGW) {
            if (it < I_GU) p0_transpose_item<true>(ffn1_wg, D, FF, W1GU, 1, ffn1_norm, scr, it, F.lane);
            else p0_transpose_item<true>(ffn1_wu, D, FF, W1GU, 2, ffn1_norm, scr, it - I_GU, F.lane);
        }
        LDS_WAIT(); asm volatile("s_waitcnt vmcnt(0)" ::: "memory"); __syncthreads();
        if (F.tid == 0) {
            unsigned nloc = bar.st[0], nx = bar.st[1];
            if (nloc == 0u) { xcd_barrier_complete(bar.bar, bar.x, nloc, nx); bar.st[0] = nloc; bar.st[1] = nx; bar.st[3] = xcd_topology_regular(bar.bar) ? 1u : 2u; }
            (void)xb_add(&bar.bar[XB_W1], 1u);
        }
        __syncthreads();
        topo = (F.MISC[11] == 1u) && F.G == 256;
        if (topo) cid = (int)(F.MISC[10] * 8u + bar.x);
        { const int pm_ = 8 * (cid & 7) + ((cid >> 3) & 7), jw = (cid >> 6) * NWAVES + F.wave;
          for (int i = 0; i < 8; ++i) {
            const int m = topo ? pm_ * 256 + jw + 32 * i : gw + i * NGW;
            const GAS f32x4* xr = (const GAS f32x4*)(x + (size_t)m * D) + F.lane;
            f32x4 v[4]; float s = 0.f;
#pragma unroll
            for (int j = 0; j < 4; ++j) { v[j] = __builtin_nontemporal_load(xr + 64 * j); s += (v[j].x * v[j].x + v[j].y * v[j].y) + (v[j].z * v[j].z + v[j].w * v[j].w); }
            s = wave_sum(s);
            GAS unsigned long long* o8 = (GAS unsigned long long*)(XB + (size_t)m * D) + F.lane;
#pragma unroll
            for (int j = 0; j < 4; ++j) o8[64 * j] = (unsigned long long)pk2(v[j].x, v[j].y) | ((unsigned long long)pk2(v[j].z, v[j].w) << 32);
            if (F.lane < 4) SS0[(size_t)m * 4 + F.lane] = F.lane == 0 ? s : 0.f;
          } }
        }
        if (BOTH(0)) { if (topo) xcd_panel_barrier(bar, pgen, 8 * (cid & 7) + ((cid >> 3) & 7), &bar.bar[XB_W1], (unsigned)F.G); else xcd_barrier(bar); }
    }
    if (IN(1)) {
        if (cid >= ((M / 256) * (NGU / 256)) % F.G) {
            const int nlo = ((M / 256) * (NGU / 256)) % F.G, ncv = F.G - nlo;
            LAS float* scr = (LAS float*)(F.lds + RING_OFF + F.wave * 16384);
            const int gw = (cid - nlo) * NWAVES + F.wave, NGW = ncv * NWAVES;
            constexpr int I_GU = (D / 64) * (FF / 32), I_DN = (FF / 64) * (D / 32), I_IN = (D / 64) * (DIN / 32), I_OUT = (D / 64) * (D / 32), I_PL = (128 / 64) * (128 / 32);
            constexpr int NITEMS = 2 * I_GU + 2 * I_DN + I_IN + I_OUT + 4 * I_PL;
            for (int it = gw; it < NITEMS; it += NGW) {
                int r = it;
                if (r < I_DN) { p0_transpose_item<true>(ffn1_wd, FF, D, W1D, 0, nullptr, scr, r, F.lane); continue; } r -= I_DN;
                if (r < I_IN) { p0_transpose_item<true>(w_in, D, DIN, WIN, 3, mix_norm, scr, r, F.lane); continue; } r -= I_IN;
                if (r < I_OUT) { p0_transpose_item<true>(w_out, D, D, WOUT, 0, nullptr, scr, r, F.lane); continue; } r -= I_OUT;
                if (r < 4 * I_PL) { const int gp = r / I_PL; p0_transpose_item<true>(pool_w + (size_t)gp * 128 * 128, 128, 128, WPOOL + (size_t)gp * 128 * 128, 0, nullptr, scr, r % I_PL, F.lane); continue; } r -= 4 * I_PL;
                if (r < I_GU) { p0_transpose_item<true>(ffn2_wg, D, FF, W2GU, 1, ffn2_norm, scr, r, F.lane); continue; } r -= I_GU;
                if (r < I_GU) { p0_transpose_item<true>(ffn2_wu, D, FF, W2GU, 2, ffn2_norm, scr, r, F.lane); continue; } r -= I_GU;
                p0_transpose_item<true>(ffn2_wd, FF, D, W2D, 0, nullptr, scr, r, F.lane);
            }
            LDS_WAIT(); asm volatile("s_waitcnt vmcnt(0)" ::: "memory");
            __syncthreads();
            if (F.tid == 0) (void)xb_add(&bar.bar[XB_CONV], 1u);
        }
        pg8::Gemm g{XB, W1GU, M, NGU, D}; pg8::StaticOrder S; S.init(M, NGU, F.G, cid);
        pg8::EpiSwiGLU E{HB, FF, SS0};
        for (int rep_ = 0; rep_ < NREP(1); ++rep_) pg8::gemm_phase<pg8::EpiSwiGLU, pg8::StaticOrder, PG8_ALIGN, PG8_SP2>(F.lds + RING_OFF, g, S, E);
        if (BOTH(1)) { if (topo) xcd_panel_barrier(bar, pgen, 8 * (cid & 7) + ((cid >> 3) & 7), &bar.bar[XB_CONV], (unsigned)(F.G - ((M / 256) * (NGU / 256)) % F.G)); else xcd_barrier(bar); }
    }
    if (IN(2)) {
        pg8::Gemm g{HB, W1D, M, D, FF}; pg8::StaticOrder S; S.init(M, D, F.G, cid);
        pg8::EpiResid<true, true> E{nullptr, XB, nullptr, XB, SS1, 0.5f};
        pg8::gemm_phase<pg8::EpiResid<true, true>, pg8::StaticOrder, PG8_ALIGN, PG8_SP2>(F.lds + RING_OFF, g, S, E);
        if (BOTH(2)) PANEL_BAR();
    }
    if (IN(3)) {
        pg8::Gemm g{XB, WIN, M, DIN, D}; pg8::StaticOrder S; S.init(M, DIN, F.G, cid); S.r1 = 1;
        pg8::EpiZ E{ZB, FF, SS1, q_norm, k_norm, QSCALE};
        pg8::gemm_phase<pg8::EpiZ, pg8::StaticOrder, PG8_ALIGN, PG8_SP2>(F.lds + RING_OFF, g, S, E);
        if (BOTH(3)) LOCAL_BAR();
    }
    if (IN(4)) {
        const int xb_ = cid & 7, rk = cid >> 3;
        if (rk < 8) {
            pg8::Gemm g{XB, WIN, M, DIN, D}; pg8::StaticOrder S; S.init(M, DIN, F.G, cid); S.r0 = 1; S.r1 = 2;
            pg8::EpiZ E{ZB, FF, SS1, q_norm, k_norm, QSCALE};
            pg8::gemm_phase<pg8::EpiZ, pg8::StaticOrder, PG8_ALIGN, PG8_SP2>(F.lds + RING_OFF, g, S, E);
        } else if (rk < 16) {
            const int a = rk - 8;
            mixp::attn_unit(F.lds + RING_OFF, ZB, YB, sinks, rel_bias, 32 * xb_ + 2 * a, -1, F.tid, F.wave, F.lane);
            mixp::attn_unit(F.lds + RING_OFF, ZB, YB, sinks, rel_bias, 32 * xb_ + 2 * a + 1, -1, F.tid, F.wave, F.lane);
        } else {
            const int p = rk - 16, pu0 = 4 * (16 * xb_ + p), pu1 = pu0 + 1;
            mixp::attn_unit(F.lds + RING_OFF, ZB, YB, sinks, rel_bias, 32 * xb_ + 16 + p, pu0, F.tid, F.wave, F.lane);
            mixp::pool_unit(F.lds + RING_OFF, ZB, YB, WPOOL, pool_scale, pu0, pu1, F.tid, F.wave, F.lane);
            mixp::pool_unit(F.lds + RING_OFF, ZB, YB, WPOOL, pool_scale, pu1, -1, F.tid, F.wave, F.lane);
        }
        if (BOTH(4)) LOCAL_BAR();
    }
    if (IN(5)) {
        pg8::Gemm g{YB, WOUT, M, D, D, FF}; pg8::StaticOrder S; S.init(M, D, F.G, cid);
        { pg8::Unit u0; S.next(0, u0);
          const int pu = 4 * (2 * u0.pm + (u0.pn >> 1)) + 2 + (u0.pn & 1);
          mixp::pool_stage(F.lds + RING_OFF, ZB, pu, F.tid);
          mixp::pool_unit(F.lds + RING_OFF, ZB, YB, WPOOL, pool_scale, pu, -1, F.tid, F.wave, F.lane);
          PANEL_BAR(); }
        pg8::EpiResid<true, true> E{nullptr, XB, nullptr, XB, SS2, 1.0f};
        pg8::gemm_phase<pg8::EpiResid<true, true>, pg8::StaticOrder, PG8_ALIGN, PG8_SP2>(F.lds + RING_OFF, g, S, E);
        if (BOTH(5)) LOCAL_BAR();
    }
    if (IN(6)) {
        pg8::Gemm g{XB, W2GU, M, NGU, D}; pg8::StaticOrder S; S.init(M, NGU, F.G, cid);
        pg8::EpiSwiGLU E{HB, FF, SS2};
        for (int rep_ = 0; rep_ < NREP(6); ++rep_) pg8::gemm_phase<pg8::EpiSwiGLU, pg8::StaticOrder, PG8_ALIGN, PG8_SP2>(F.lds + RING_OFF, g, S, E);
        if (BOTH(6)) PANEL_BAR();
    }
    if (IN(7)) {
        pg8::Gemm g{HB, W2D, M, D, FF}; pg8::StaticOrder S; S.init(M, D, F.G, cid);
        pg8::EpiResid<true, false> E{nullptr, XB, out, nullptr, nullptr, 0.5f};
        for (int rep_ = 0; rep_ < NREP(7); ++rep_) pg8::gemm_phase<pg8::EpiResid<true, false>, pg8::StaticOrder, PG8_ALIGN, PG8_SP2>(F.lds + RING_OFF, g, S, E);
    }
#undef IN
#undef BOTH
#undef GRID_BAR
}

extern "C" void kernel_launch(void* const* d_in, const int* in_sizes, int n_in, void* d_out, int out_size, void* d_ws, size_t ws_size, hipStream_t stream) {
    static int grid = 0;
    if (grid == 0) {
        if (n_in != 18 || in_sizes[0] != M * D || out_size != M * D || ws_size < WS_END) { fprintf(stderr, "kernel_launch: unexpected shapes (n_in %d, in0 %d, out %d, ws %zu); nothing launched\n", n_in, n_in > 0 ? in_sizes[0] : -1, out_size, ws_size); grid = -1; return; }
        int dev = 0, cus = 0, per_cu = 0;
        if (hipGetDevice(&dev) != hipSuccess || hipDeviceGetAttribute(&cus, hipDeviceAttributeMultiprocessorCount, dev) != hipSuccess) { grid = -1; return; }
        if (hipFuncSetAttribute((const void*)mega_fwd, hipFuncAttributeMaxDynamicSharedMemorySize, LDS_BYTES) != hipSuccess) { fprintf(stderr, "kernel_launch: hipFuncSetAttribute failed\n"); grid = -1; return; }
        if (hipOccupancyMaxActiveBlocksPerMultiprocessor(&per_cu, (const void*)mega_fwd, NWAVES * 64, LDS_BYTES) != hipSuccess || per_cu < 1)
            fprintf(stderr, "kernel_launch: note: occupancy query reports %d workgroups per CU\n", per_cu);
        (void)hipGetLastError();
        grid = cus;
        if (grid != 256) fprintf(stderr, "kernel_launch: note: %d CUs (tuned for 256)\n", grid);
    }
    if (grid < 0) return;
    if (hipMemsetAsync((char*)d_ws + WS_CTL, 0, CTL_ZERO_BYTES, stream) != hipSuccess) { fprintf(stderr, "kernel_launch: hipMemsetAsync failed\n"); return; }
    Args a{};
    for (int i = 0; i < 18; ++i) a.in[i] = (const float*)d_in[i];
    a.out = (float*)d_out; a.ws = (unsigned char*)d_ws;
    for (int li = 0; li < N_LAUNCHES; ++li) {
        if (N_LAUNCHES == PER_PHASE) { a.ph_lo = li; a.ph_hi = li + 1; } else { a.ph_lo = 0; a.ph_hi = PER_PHASE; }
        a.li = li;
        hipLaunchKernelGGL(mega_fwd, dim3(grid), dim3(NWAVES * 64), LDS_BYTES, stream, a);
        const hipError_t le = hipPeekAtLastError();
        if (le != hipSuccess) { fprintf(stderr, "kernel_launch: launch %d failed: %s\n", li, hipGetErrorName(le)); break; }
    }
}
```

```cpp
#include <hip/hip_runtime.h>
#ifndef DRAIN_BEFORE_STORE
#define DRAIN_BEFORE_STORE 1
#endif
#include <cstdio>
#include <cstdint>

#ifndef MK_N_LAUNCHES
#define MK_N_LAUNCHES 1
#endif
#ifndef PROBE_REP
#define PROBE_REP -1
#endif
#ifndef PROBE_XBAR
#define PROBE_XBAR 0
#endif
#define NREP(k) ((k) == PROBE_REP ? 2 : 1)
#define rep_first(k) true

namespace pg8 {
#define PG8_LAS __attribute__((address_space(3)))
typedef unsigned short bf16_t;
typedef short bf16x8 __attribute__((ext_vector_type(8)));
typedef float f32x4 __attribute__((ext_vector_type(4)));
typedef unsigned u32x4 __attribute__((ext_vector_type(4)));
typedef unsigned u32x2 __attribute__((ext_vector_type(2)));
constexpr int BM = 256, BK = 64, HALF = 128, HTB = HALF * BK * 2, STAGE_BYTES = 8 * HTB, NXCD = 8, WGM = 8;

__host__ __device__ __forceinline__ int lds_byte(int r, int c) { const int st = (r >> 4) * 2 + (c >> 5), rr = r & 15, cc = c & 31, ob = rr * 64 + cc * 2; return st * 1024 + (ob ^ (((ob >> 9) & 1) << 5)); }
__host__ __device__ __forceinline__ void stage_rc(int b, int& R, int& C) { const int st = b / 1024, sb = b % 1024, swz = sb ^ (((sb >> 9) & 1) << 5); R = (st >> 1) * 16 + swz / 64; C = (st & 1) * 32 + (swz % 64) / 2; }
__host__ __device__ __forceinline__ int perm32(int rho) { const int n = rho >> 4, i = rho & 15; return 8 * (i >> 2) + 4 * n + (i & 3); }

struct Unit { int pm, pn; };
struct Gemm { const bf16_t* A; const bf16_t* Bt; int M, N, K; int lda = 0; bool rev = false; };

struct StaticOrder {
    int nM, nN, nwg, G, c, r0 = 0, r1 = 1 << 20;
    __host__ __device__ void init(int M, int N, int G_, int c_) { nM = M / BM; nN = N / BM; nwg = nM * nN; G = G_; c = c_; }
    __host__ __device__ bool next(int i, Unit& u) const {
        if (r0 + i >= r1) return false;
        const long L = (long)(r0 + i) * G + c; if (L >= nwg) return false;
        int wgid = (int)L; { const int q = nwg / NXCD, r = nwg % NXCD, xcd = wgid % NXCD, off = wgid / NXCD; wgid = (xcd < r ? xcd * (q + 1) : r * (q + 1) + (xcd - r) * q) + off; }
        const int nig = WGM * nN, gid = wgid / nig, fm = gid * WGM, gsz = (nM - fm) < WGM ? (nM - fm) : WGM;
        u.pm = fm + ((wgid % nig) % gsz); u.pn = (wgid % nig) / gsz; return true;
    }
    __device__ __forceinline__ void a_ready(const Unit&) const {}
    __device__ __forceinline__ void done(const Unit&) const {}
};

#define WT_RSRC(p) __builtin_amdgcn_make_buffer_rsrc((void*)(p), 0, 0x7ffffff0, 0x00020000)
#define WT_ST16(rs, byteoff, v) __builtin_amdgcn_raw_buffer_store_b128((v), (rs), (int)(byteoff), 0, 16)
__device__ __forceinline__ unsigned cvt_pk_bf16(float lo, float hi) { unsigned r; asm volatile("v_cvt_pk_bf16_f32 %0, %1, %2" : "=v"(r) : "v"(lo), "v"(hi)); return r; }

struct RstdPre { f32x4 t[2]; };
struct NoPre {};
__device__ __forceinline__ void rstd_prefetch(RstdPre& p, const float* ss, int rowbase, int lane) {
    p.t[0] = *(const f32x4*)(ss + (size_t)(rowbase + lane) * 4); p.t[1] = *(const f32x4*)(ss + (size_t)(rowbase + 128 + lane) * 4);
}
__device__ __forceinline__ void rstd_finish(const RstdPre& p, int fr, float (&rs)[2][4]) {
    float v[2];
#pragma unroll
    for (int ai = 0; ai < 2; ++ai) { const f32x4 a = p.t[ai]; v[ai] = __builtin_amdgcn_rsqf(((a[0] + a[1]) + (a[2] + a[3])) * (1.0f / 1024.0f) + 1e-6f); }
#pragma unroll
    for (int ai = 0; ai < 2; ++ai)
#pragma unroll
        for (int m = 0; m < 4; ++m) rs[ai][m] = __shfl(v[ai], 16 * m + fr);
}

struct EpiSwiGLU {
    static constexpr bool PERM = true, AFTER_DRAIN = false;
    typedef RstdPre Pre;
    bf16_t* H; int ldh; const float* ss;
    __device__ __forceinline__ void prefetch(Pre& p, const Unit& u, int wr, int lane) const { rstd_prefetch(p, ss, u.pm * BM + wr * 64, lane); }
    __device__ __forceinline__ void operator()(const f32x4 (&acc)[2][2][4][2], const Pre& p, const Unit& u, int wr, int wc, int fr, int fq) const {
        const int row0 = u.pm * BM + wr * 64 + fr, col0 = u.pn * HALF + wc * 32 + 8 * fq;
        float rsv[2][4]; rstd_finish(p, fr, rsv);
#pragma unroll
        for (int ai = 0; ai < 2; ++ai)
#pragma unroll
            for (int m = 0; m < 4; ++m) {
                const int row = row0 + ai * HALF + m * 16; const float rs = rsv[ai][m], c1 = rs * -1.4426950408889634f, rs2 = rs * rs;
                f32x4 h[2];
#pragma unroll
                for (int n = 0; n < 2; ++n) {
                    const f32x4 g = acc[ai][0][m][n], uu = acc[ai][1][m][n];
                    const f32x4 t = g * c1;
                    f32x4 e; e[0] = __builtin_amdgcn_exp2f(t[0]); e[1] = __builtin_amdgcn_exp2f(t[1]); e[2] = __builtin_amdgcn_exp2f(t[2]); e[3] = __builtin_amdgcn_exp2f(t[3]);
                    const f32x4 d = e + 1.0f;
                    f32x4 r; r[0] = __builtin_amdgcn_rcpf(d[0]); r[1] = __builtin_amdgcn_rcpf(d[1]); r[2] = __builtin_amdgcn_rcpf(d[2]); r[3] = __builtin_amdgcn_rcpf(d[3]);
                    h[n] = ((g * uu) * rs2) * r;
                }
                u32x4 w;
                w.x = cvt_pk_bf16(h[0][0], h[0][1]); w.y = cvt_pk_bf16(h[0][2], h[0][3]); w.z = cvt_pk_bf16(h[1][0], h[1][1]); w.w = cvt_pk_bf16(h[1][2], h[1][3]);
                *(u32x4*)(H + (size_t)row * ldh + col0) = w;
            }
    }
};
struct EpiZ {
    static constexpr bool PERM = true, AFTER_DRAIN = false;
    typedef RstdPre Pre;
    bf16_t* Z; int ldz; const float* ss; const float* qg; const float* kg; float qscale;
    __device__ __forceinline__ void prefetch(Pre& p, const Unit& u, int wr, int lane) const { rstd_prefetch(p, ss, u.pm * BM + wr * 64, lane); }
    __device__ __forceinline__ void operator()(const f32x4 (&acc)[2][2][4][2], const Pre& p, const Unit& u, int wr, int wc, int fr, int fq) const {
        const int row0 = u.pm * BM + wr * 64 + fr, slot = u.pn * 4 + wc, col0 = slot * 64 + 8 * fq;
        const int kind = slot < 8 ? 0 : (slot < 10 ? 1 : 2);
        f32x4 gv[2][2];
#pragma unroll
        for (int bj = 0; bj < 2; ++bj)
#pragma unroll
            for (int n = 0; n < 2; ++n) {
                if (kind < 2) { const f32x4 t = *(const f32x4*)((kind == 0 ? qg : kg) + 32 * bj + 8 * fq + 4 * n); gv[bj][n] = kind == 0 ? t * qscale : t; }
                else gv[bj][n] = (f32x4){1.f, 1.f, 1.f, 1.f};
            }
        float rsv[2][4]; rstd_finish(p, fr, rsv);
#pragma unroll
        for (int ai = 0; ai < 2; ++ai)
#pragma unroll
            for (int m = 0; m < 4; ++m) {
                const int row = row0 + ai * HALF + m * 16; const float rs = rsv[ai][m];
                f32x4 v[2][2]; float q = 0.f;
#pragma unroll
                for (int bj = 0; bj < 2; ++bj)
#pragma unroll
                    for (int n = 0; n < 2; ++n) { v[bj][n] = acc[ai][bj][m][n] * rs; const f32x4 t = v[bj][n]; q += (t[0] * t[0] + t[1] * t[1]) + (t[2] * t[2] + t[3] * t[3]); }
                if (kind < 2) {
                    q += __shfl_xor(q, 16); q += __shfl_xor(q, 32);
                    const float rn = __builtin_amdgcn_rsqf(q * (1.0f / 64.0f) + 1e-6f);
#pragma unroll
                    for (int bj = 0; bj < 2; ++bj)
#pragma unroll
                        for (int n = 0; n < 2; ++n) v[bj][n] = v[bj][n] * rn * gv[bj][n];
                }
#pragma unroll
                for (int bj = 0; bj < 2; ++bj) {
                    u32x4 w; w.x = cvt_pk_bf16(v[bj][0][0], v[bj][0][1]); w.y = cvt_pk_bf16(v[bj][0][2], v[bj][0][3]); w.z = cvt_pk_bf16(v[bj][1][0], v[bj][1][1]); w.w = cvt_pk_bf16(v[bj][1][2], v[bj][1][3]);
                    *(u32x4*)(Z + (size_t)row * ldz + col0 + 32 * bj) = w;
                }
            }
    }
};
template <bool RBF, bool OBF> struct EpiResid {
    static constexpr bool PERM = true, AFTER_DRAIN = OBF;
    typedef NoPre Pre;
    const float* R; const bf16_t* Rb; float* out; bf16_t* xb; float* ss; float alpha;
    __device__ __forceinline__ void prefetch(Pre&, const Unit&, int, int) const {}
    __device__ __forceinline__ void operator()(const f32x4 (&acc)[2][2][4][2], const Pre&, const Unit& u, int wr, int wc, int fr, int fq) const { body(acc, u, wr, wc, fr, fq, nullptr); }
    __device__ __forceinline__ void fused(const f32x4 (&acc)[2][2][4][2], const Unit& u, int wr, int wc, int fr, int fq, PG8_LAS unsigned char* lds, int wid, int lane) const {
        body(acc, u, wr, wc, fr, fq, (PG8_LAS float*)lds);
        asm volatile("s_waitcnt lgkmcnt(0)" ::: "memory"); __builtin_amdgcn_s_barrier(); asm volatile("" ::: "memory");
        const int t = wid * 64 + lane;
        if (t < 256) { const f32x4 p = ((const PG8_LAS f32x4*)lds)[t]; ss[(size_t)(u.pm * BM + t) * 4 + u.pn] = (p[0] + p[1]) + (p[2] + p[3]); }
    }
    __device__ __forceinline__ void body(const f32x4 (&acc)[2][2][4][2], const Unit& u, int wr, int wc, int fr, int fq, PG8_LAS float* P) const {
        const int row0 = u.pm * BM + wr * 64 + fr, col0 = u.pn * BM + wc * 32 + 8 * fq;
        f32x4 rf[3][2][2]; u32x4 rh[3][2];
#define PG8_RLOAD(i) do { const size_t off_ = (size_t)(row0 + ((i) >> 2) * HALF + ((i) & 3) * 16) * 1024 + col0; _Pragma("unroll") for (int bj = 0; bj < 2; ++bj) { \
            if (RBF) rh[(i) % 3][bj] = *(const u32x4*)(Rb + off_ + bj * HALF); \
            else { rf[(i) % 3][bj][0] = *(const f32x4*)(R + off_ + bj * HALF); rf[(i) % 3][bj][1] = *(const f32x4*)(R + off_ + bj * HALF + 4); } } } while (0)
        PG8_RLOAD(0); PG8_RLOAD(1);
#pragma unroll
        for (int i = 0; i < 8; ++i) {
            const int ai = i >> 2, m = i & 3;
            if (i + 2 < 8) PG8_RLOAD(i + 2);
            asm volatile("" ::: "memory");
            const int row = row0 + ai * HALF + m * 16; const size_t off = (size_t)row * 1024 + col0; float q = 0.f;
#pragma unroll
            for (int bj = 0; bj < 2; ++bj) {
                f32x4 r0, r1;
                if (RBF) { const u32x4 h = rh[i % 3][bj];
                    r0 = (f32x4){__builtin_bit_cast(float, h.x << 16), __builtin_bit_cast(float, h.x & 0xffff0000u), __builtin_bit_cast(float, h.y << 16), __builtin_bit_cast(float, h.y & 0xffff0000u)};
                    r1 = (f32x4){__builtin_bit_cast(float, h.z << 16), __builtin_bit_cast(float, h.z & 0xffff0000u), __builtin_bit_cast(float, h.w << 16), __builtin_bit_cast(float, h.w & 0xffff0000u)}; }
                else { r0 = rf[i % 3][bj][0]; r1 = rf[i % 3][bj][1]; }
                const f32x4 o0 = r0 + acc[ai][bj][m][0] * alpha, o1 = r1 + acc[ai][bj][m][1] * alpha;
                if (OBF) {
                    u32x4 w; w.x = cvt_pk_bf16(o0[0], o0[1]); w.y = cvt_pk_bf16(o0[2], o0[3]); w.z = cvt_pk_bf16(o1[0], o1[1]); w.w = cvt_pk_bf16(o1[2], o1[3]);
                    *(u32x4*)(xb + off + bj * HALF) = w;
#pragma unroll
                    for (int e = 0; e < 4; ++e) { const float lo = __builtin_bit_cast(float, w[e] << 16), hi = __builtin_bit_cast(float, w[e] & 0xffff0000u); q += lo * lo + hi * hi; }
                } else { __builtin_nontemporal_store(o0, (f32x4*)(out + off + bj * HALF)); __builtin_nontemporal_store(o1, (f32x4*)(out + off + bj * HALF + 4)); }
            }
            if (OBF) { q += __shfl_xor(q, 16); q += __shfl_xor(q, 32); if (fq == 0) P[(ai * HALF + wr * 64 + m * 16 + fr) * 4 + wc] = q; }
            asm volatile("" ::: "memory");
        }
#undef PG8_RLOAD
    }
};

template <class Epi, class Sched, bool ALIGN_EPI = false, bool SP2 = false>
__device__ __forceinline__ void gemm_phase(PG8_LAS unsigned char* lds, const Gemm g, const Sched& S, const Epi& E) {
    const int tid = threadIdx.x, wid = __builtin_amdgcn_readfirstlane(tid >> 6), lane = tid & 63, wr = wid >> 2, wc = wid & 3, fr = lane & 15, fq = lane >> 4;
    const int K = g.K, nt = K / BK, lda = g.lda ? g.lda : g.K;
    unsigned voffA[2], voffB[2];
#pragma unroll
    for (int i = 0; i < 2; ++i) { int R, C; stage_rc(tid * 16 + i * 8192, R, C); const int Rb = Epi::PERM ? ((R & ~31) + perm32(R & 31)) : R;
        voffA[i] = (unsigned)(R * lda + C) * 2u; voffB[i] = (unsigned)(Rb * K + C) * 2u; }
    const unsigned kstep = g.rev ? 0u - (unsigned)(BK * 2) : (unsigned)(BK * 2), kfirst = g.rev ? (unsigned)(nt - 1) * (unsigned)(BK * 2) : 0u;
    const unsigned hstep = (unsigned)HALF * K * 2, hstepA = (unsigned)HALF * lda * 2;
    const unsigned tstep = 2 * hstep, tstepA = 2 * hstepA;
    const __amdgpu_buffer_rsrc_t rA = WT_RSRC(g.A), rB = WT_RSRC(g.Bt);
    const unsigned ldsw = (unsigned)wid * 1024u;
    const int aoff = lds_byte(wr * 64 + fr, fq * 8), boff = lds_byte(wc * 32 + fr, fq * 8);
#define PG8_SA(b, h) (((b) * 2 + (h)) * HTB)
#define PG8_SB(b, h) ((4 + (b) * 2 + (h)) * HTB)
#define PG8_STAGE_A(bufoff, soff) do { _Pragma("unroll") for (int _i = 0; _i < 2; ++_i) \
        __builtin_amdgcn_raw_ptr_buffer_load_lds(rA, (PG8_LAS void*)(lds + (bufoff) + ldsw + _i * 8192), 16, (int)voffA[_i], (int)(soff), 0, 0); } while (0)
#define PG8_STAGE_B(bufoff, soff) do { _Pragma("unroll") for (int _i = 0; _i < 2; ++_i) \
        __builtin_amdgcn_raw_ptr_buffer_load_lds(rB, (PG8_LAS void*)(lds + (bufoff) + ldsw + _i * 8192), 16, (int)voffB[_i], (int)(soff), 0, 0); } while (0)
#define PG8_LDA(dst, b, h) do { _Pragma("unroll") for (int m = 0; m < 4; ++m) _Pragma("unroll") for (int k = 0; k < 2; ++k) dst[m][k] = *(const PG8_LAS bf16x8*)(lds + PG8_SA(b, h) + aoff + m * 2048 + k * 1024); } while (0)
#define PG8_LDB(dst, b, h) do { _Pragma("unroll") for (int n = 0; n < 2; ++n) _Pragma("unroll") for (int k = 0; k < 2; ++k) dst[n][k] = *(const PG8_LAS bf16x8*)(lds + PG8_SB(b, h) + boff + n * 2048 + k * 1024); } while (0)
#define PG8_MMA(ai, bj, At, Bt) do { __builtin_amdgcn_s_setprio(3); _Pragma("unroll") for (int k = 0; k < 2; ++k) _Pragma("unroll") for (int m = 0; m < 4; ++m) _Pragma("unroll") for (int n = 0; n < 2; ++n) \
        acc[ai][bj][m][n] = __builtin_amdgcn_mfma_f32_16x16x32_bf16(Bt[n][k], At[m][k], acc[ai][bj][m][n], 0, 0, 0); __builtin_amdgcn_s_setprio(0); } while (0)
#define PG8_WAIT_V(n) asm volatile("s_waitcnt vmcnt(" #n ")" ::: "memory")
#define PG8_WAIT_L(n) asm volatile("s_waitcnt lgkmcnt(" #n ")" ::: "memory")
#define PG8_BAR __builtin_amdgcn_s_barrier()
#define PG8_SCHED __builtin_amdgcn_sched_barrier(0)
    Unit cur, nxt; int ui = 0;
    if (!S.next(0, cur)) return;
    f32x4 acc[2][2][4][2];
#pragma unroll
    for (int a = 0; a < 2; ++a)
#pragma unroll
        for (int b = 0; b < 2; ++b)
#pragma unroll
            for (int m = 0; m < 4; ++m)
#pragma unroll
                for (int n = 0; n < 2; ++n) acc[a][b][m][n] = (f32x4){0.f, 0.f, 0.f, 0.f};
    bf16x8 At[4][2], B0[2][2], B1[2][2];
    typename Epi::Pre pre;
    unsigned cA = (unsigned)cur.pm * tstepA + kfirst, cB = (unsigned)cur.pn * tstep + kfirst;
    S.a_ready(cur);
    if constexpr (SP2) {
        PG8_STAGE_B(PG8_SB(0, 0), cB); PG8_STAGE_B(PG8_SB(0, 1), cB + hstep); PG8_STAGE_A(PG8_SA(0, 0), cA); PG8_STAGE_A(PG8_SA(0, 1), cA + hstepA);
        if (wr == 1) PG8_BAR;
        PG8_WAIT_V(2); PG8_BAR;
        PG8_STAGE_B(PG8_SB(1, 0), cB + kstep); PG8_STAGE_A(PG8_SA(1, 0), cA + kstep); PG8_STAGE_B(PG8_SB(1, 1), cB + hstep + kstep);
        PG8_WAIT_V(6); PG8_BAR;
    } else {
        PG8_STAGE_B(PG8_SB(0, 0), cB); PG8_STAGE_A(PG8_SA(0, 0), cA); PG8_STAGE_B(PG8_SB(0, 1), cB + hstep); PG8_STAGE_A(PG8_SA(0, 1), cA + hstepA);
        if (wr == 1) PG8_BAR;
        PG8_WAIT_V(4); PG8_BAR;
        PG8_STAGE_B(PG8_SB(1, 0), cB + kstep); PG8_STAGE_A(PG8_SA(1, 0), cA + kstep); PG8_STAGE_B(PG8_SB(1, 1), cB + hstep + kstep);
        PG8_WAIT_V(6); PG8_BAR;
    }
    for (;;) {
        const bool has_next = S.next(ui + 1, nxt);
        const unsigned nA = has_next ? (unsigned)nxt.pm * tstepA + kfirst : cA, nB = has_next ? (unsigned)nxt.pn * tstep + kfirst : cB;
        int t_begin = 0;
        if constexpr (SP2 && !Epi::AFTER_DRAIN) { if (DRAIN_BEFORE_STORE && ui > 0) {
            const unsigned a1 = cA + kstep, a2 = cA + 2u * kstep, b2 = cB + 2u * kstep, a3 = a2 + kstep, b3 = b2 + kstep;
            PG8_LDB(B0, 0, 0); PG8_LDB(B1, 0, 1); PG8_SCHED; PG8_LDA(At, 0, 0); PG8_STAGE_A(PG8_SA(1, 1), a1 + hstepA);
            PG8_WAIT_L(0); PG8_BAR; PG8_MMA(0, 0, At, B0); PG8_MMA(0, 1, At, B1); PG8_BAR; PG8_SCHED;
            PG8_LDA(At, 0, 1); PG8_STAGE_B(PG8_SB(0, 0), b2); PG8_STAGE_B(PG8_SB(0, 1), b2 + hstep); PG8_STAGE_A(PG8_SA(0, 0), a2);
            PG8_WAIT_L(0); PG8_BAR; PG8_MMA(1, 0, At, B0); PG8_MMA(1, 1, At, B1); PG8_BAR; PG8_SCHED;
            PG8_LDB(B0, 1, 0); PG8_LDB(B1, 1, 1); PG8_SCHED; PG8_LDA(At, 1, 0); PG8_STAGE_A(PG8_SA(0, 1), a2 + hstepA);
            PG8_WAIT_V(8); PG8_WAIT_L(0); PG8_BAR; PG8_MMA(0, 0, At, B0); PG8_MMA(0, 1, At, B1); PG8_BAR; PG8_SCHED;
            PG8_LDA(At, 1, 1); PG8_STAGE_B(PG8_SB(1, 0), b3); PG8_STAGE_B(PG8_SB(1, 1), b3 + hstep); PG8_STAGE_A(PG8_SA(1, 0), a3);
            PG8_WAIT_V(8); PG8_WAIT_L(0); PG8_BAR; PG8_MMA(1, 0, At, B0); PG8_MMA(1, 1, At, B1); PG8_BAR; PG8_SCHED;
            t_begin = 2;
        } }
        for (int t = t_begin; t < nt; t += 2) {
            const bool last = (t == nt - 2);
            const unsigned a1 = cA + (unsigned)(t + 1) * kstep;
            const unsigned a2 = last ? nA : cA + (unsigned)(t + 2) * kstep, b2 = last ? nB : cB + (unsigned)(t + 2) * kstep;
            const unsigned a3 = a2 + kstep, b3 = b2 + kstep;
            if (last && has_next) S.a_ready(nxt);
            if (last) E.prefetch(pre, cur, wr, lane);
            if constexpr (SP2) {
            PG8_LDB(B0, 0, 0); PG8_LDB(B1, 0, 1); PG8_SCHED; PG8_LDA(At, 0, 0); PG8_STAGE_A(PG8_SA(1, 1), a1 + hstepA);
            PG8_WAIT_V(8); PG8_WAIT_L(0); PG8_BAR; PG8_MMA(0, 0, At, B0); PG8_MMA(0, 1, At, B1); PG8_BAR; PG8_SCHED;
            PG8_LDA(At, 0, 1); PG8_STAGE_B(PG8_SB(0, 0), b2); PG8_STAGE_B(PG8_SB(0, 1), b2 + hstep); PG8_STAGE_A(PG8_SA(0, 0), a2);
            PG8_WAIT_V(8); PG8_WAIT_L(0); PG8_BAR; PG8_MMA(1, 0, At, B0); PG8_MMA(1, 1, At, B1); PG8_BAR; PG8_SCHED;
            PG8_LDB(B0, 1, 0); PG8_LDB(B1, 1, 1); PG8_SCHED; PG8_LDA(At, 1, 0); PG8_STAGE_A(PG8_SA(0, 1), a2 + hstepA);
            PG8_WAIT_V(8); PG8_WAIT_L(0); PG8_BAR; PG8_MMA(0, 0, At, B0); PG8_MMA(0, 1, At, B1); PG8_BAR; PG8_SCHED;
            PG8_LDA(At, 1, 1); PG8_STAGE_B(PG8_SB(1, 0), b3); PG8_STAGE_B(PG8_SB(1, 1), b3 + hstep); PG8_STAGE_A(PG8_SA(1, 0), a3);
            PG8_WAIT_V(8); PG8_WAIT_L(0); PG8_BAR; PG8_MMA(1, 0, At, B0); PG8_MMA(1, 1, At, B1); PG8_BAR; PG8_SCHED;
            } else {
            PG8_LDB(B0, 0, 0); PG8_SCHED; PG8_LDA(At, 0, 0); PG8_STAGE_A(PG8_SA(1, 1), a1 + hstepA);
            PG8_WAIT_L(8); PG8_BAR; PG8_WAIT_L(0); PG8_MMA(0, 0, At, B0); PG8_BAR; PG8_SCHED;
            PG8_LDB(B1, 0, 1); PG8_STAGE_B(PG8_SB(0, 0), b2);
            PG8_BAR; PG8_WAIT_L(0); PG8_MMA(0, 1, At, B1); PG8_BAR;
            PG8_LDA(At, 0, 1); PG8_STAGE_A(PG8_SA(0, 0), a2);
            PG8_BAR; PG8_WAIT_L(0); PG8_MMA(1, 0, At, B0); PG8_BAR; PG8_SCHED;
            PG8_STAGE_B(PG8_SB(0, 1), b2 + hstep);
            PG8_WAIT_V(6); PG8_BAR; PG8_MMA(1, 1, At, B1); PG8_BAR;
            PG8_LDB(B0, 1, 0); PG8_SCHED; PG8_LDA(At, 1, 0); PG8_STAGE_A(PG8_SA(0, 1), a2 + hstepA);
            PG8_WAIT_L(8); PG8_BAR; PG8_WAIT_L(0); PG8_MMA(0, 0, At, B0); PG8_BAR; PG8_SCHED;
            PG8_LDB(B1, 1, 1); PG8_STAGE_B(PG8_SB(1, 0), b3);
            PG8_BAR; PG8_WAIT_L(0); PG8_MMA(0, 1, At, B1); PG8_BAR;
            PG8_LDA(At, 1, 1); PG8_STAGE_A(PG8_SA(1, 0), a3);
            PG8_BAR; PG8_WAIT_L(0); PG8_MMA(1, 0, At, B0); PG8_BAR; PG8_SCHED;
            PG8_STAGE_B(PG8_SB(1, 1), b3 + hstep);
            PG8_WAIT_V(6); PG8_BAR; PG8_MMA(1, 1, At, B1); PG8_BAR;
            }
        }
        if constexpr (ALIGN_EPI) { if (wr == 0) PG8_BAR; }
        if constexpr (!Epi::AFTER_DRAIN) { if (DRAIN_BEFORE_STORE && has_next) PG8_WAIT_V(0); E(acc, pre, cur, wr, wc, fr, fq); S.done(cur); }
        if (!has_next) break;
#pragma unroll
        for (int a = 0; a < 2; ++a)
#pragma unroll
            for (int b = 0; b < 2; ++b)
#pragma unroll
                for (int m = 0; m < 4; ++m)
#pragma unroll
                    for (int n = 0; n < 2; ++n) acc[a][b][m][n] = (f32x4){0.f, 0.f, 0.f, 0.f};
        cur = nxt; cA = nA; cB = nB; ++ui;
        if constexpr (ALIGN_EPI) { if (wr == 1) PG8_BAR; }
    }
    PG8_WAIT_V(0);
    if constexpr (!ALIGN_EPI) { if (wr == 0) PG8_BAR; }
    PG8_BAR;
    if constexpr (Epi::AFTER_DRAIN) { E.fused(acc, cur, wr, wc, fr, fq, lds, wid, lane); S.done(cur); asm volatile("s_waitcnt lgkmcnt(0)" ::: "memory"); PG8_BAR; }
#undef PG8_SA
#undef PG8_SB
#undef PG8_STAGE_A
#undef PG8_STAGE_B
#undef PG8_LDA
#undef PG8_LDB
#undef PG8_MMA
#undef PG8_WAIT_V
#undef PG8_WAIT_L
#undef PG8_BAR
#undef PG8_SCHED
}
}

#ifndef PG8_SP2
#define PG8_SP2 true
#endif
#ifndef PG8_ALIGN
#define PG8_ALIGN true
#endif

constexpr int NWAVES = 8;
constexpr int N_LAUNCHES = 1;
constexpr int PER_PHASE = 8;
constexpr int M = 16384, D = 1024, FF = 2816, DIN = 1280, SEQ = 2048;
constexpr int NGU = 2 * FF;
constexpr float LOG2E = 1.4426950408889634f;
constexpr float QSCALE = 0.125f * LOG2E;

constexpr size_t MiB = 1u << 20;
constexpr size_t WS_CTL = 0, CTL_ZERO_BYTES = 53248;
constexpr size_t WS_W1GU = 2 * MiB;
constexpr size_t WS_W1D = 14 * MiB;
constexpr size_t WS_WIN = 20 * MiB;
constexpr size_t WS_WOUT = 23 * MiB;
constexpr size_t WS_W2GU = 26 * MiB;
constexpr size_t WS_W2D = 38 * MiB;
constexpr size_t WS_WPOOL = 44 * MiB;
constexpr size_t WS_SS0 = 45 * MiB, WS_SS1 = 46 * MiB, WS_SS2 = 47 * MiB;
constexpr size_t WS_XB = 48 * MiB;
constexpr size_t WS_H = 80 * MiB;
constexpr size_t WS_END = 168 * MiB;
static_assert(WS_H + (size_t)M * FF * 2 <= WS_END && (D + DIN) <= FF, "d_ws map");
constexpr int CW_BAR = 4096;

constexpr int RING_OFF = 0, RING_BYTES = 131072;
constexpr int LDSCTL_OFF = RING_BYTES, MISC_OFF = LDSCTL_OFF + 320;
constexpr int LDS_BYTES = 147456;

#define GAS __attribute__((address_space(1)))
#define LAS __attribute__((address_space(3)))
typedef unsigned short bf16;
typedef unsigned v4u __attribute__((ext_vector_type(4)));
typedef unsigned v2u __attribute__((ext_vector_type(2)));
typedef float f32x4 __attribute__((ext_vector_type(4)));
typedef float f32x16 __attribute__((ext_vector_type(16)));
typedef short bf16x8 __attribute__((ext_vector_type(8)));
typedef short s16x4 __attribute__((ext_vector_type(4)));
typedef GAS unsigned gu32;
#define RLX_AGENT __ATOMIC_RELAXED, __HIP_MEMORY_SCOPE_AGENT
#define LDS_WAIT() asm volatile("s_waitcnt lgkmcnt(0)" ::: "memory")
#define VM_WAIT() asm volatile("s_waitcnt vmcnt(0)" ::: "memory")
__device__ __forceinline__ unsigned f2bf(float f) { unsigned u = __builtin_bit_cast(unsigned, f); return (u + 0x7fffu + ((u >> 16) & 1u)) >> 16; }
__device__ __forceinline__ unsigned pk2(float lo, float hi) { return f2bf(lo) | (f2bf(hi) << 16); }
__device__ __forceinline__ float bf2f(unsigned short b) { return __builtin_bit_cast(float, (unsigned)b << 16); }

#define XB_TMO      128
#define XB_XCNT(j)  (256  + 64 * (j))
#define XB_XSUB(j)  (1280 + 64 * (j))
#define XB_XGEN(j)  (2304 + 64 * (j))
#define XB_TOP      3328
#define XB_TOPGEN   3392
#define XCD_BAR_WORDS 3456
#define XB_PNL(p)   (4544 + 64 * (p))
#define XB_W1       (4544 + 64 * 64)
#define XB_CONV     (3456 + 64 * 16)
#define XB_LOC(j)   (3456 + 64 * (j))
#define XB_SPIN_CAP (1u << 18)
__device__ __forceinline__ unsigned xb_ld(unsigned* p)              { return __hip_atomic_load(p, __ATOMIC_RELAXED, __HIP_MEMORY_SCOPE_AGENT); }
__device__ __forceinline__ unsigned xb_add(unsigned* p, unsigned v) { return __hip_atomic_fetch_add(p, v, __ATOMIC_RELAXED, __HIP_MEMORY_SCOPE_AGENT); }
__device__ __forceinline__ unsigned xb_xcc_id() { return (unsigned)__builtin_amdgcn_s_getreg((3 << 11) | 20) & 0xFu; }
#define XB_SPIN(cond, bar) do { unsigned _sp = 0; while (cond) { __builtin_amdgcn_s_sleep(1); \
    if ((++_sp & 255u) == 0u) { if (xb_ld(&(bar)[XB_TMO])) break; if (_sp > XB_SPIN_CAP) { atomicAdd(&(bar)[XB_TMO], 1u); break; } } } } while (0)
struct XcdBarrier { unsigned* bar; unsigned x; volatile LAS unsigned* st; };
__device__ __forceinline__ XcdBarrier xcd_barrier_post(unsigned* bar, volatile LAS unsigned* st) {
    XcdBarrier b; b.bar = bar; b.x = xb_xcc_id(); b.st = st;
    if (threadIdx.x == 0) st[2] = xb_add(&bar[XB_XCNT(b.x)], 1u);
    return b;
}
__device__ __forceinline__ void xcd_barrier_complete(unsigned* bar, unsigned x, unsigned& nloc, unsigned& nx) {
    const unsigned G = gridDim.x * gridDim.y * gridDim.z;
    unsigned sum, cnt, mine, sp = 0u;
    for (;;) {
        sum = 0u; cnt = 0u; mine = 0u;
#pragma unroll
        for (unsigned j = 0; j < 16; ++j) { const unsigned c = xb_ld(&bar[XB_XCNT(j)]); sum += c; cnt += (c > 0u) ? 1u : 0u; mine = (j == x) ? c : mine; }
        if (sum == G) break;
        __builtin_amdgcn_s_sleep(1);
        if ((++sp & 255u) == 0u) { if (xb_ld(&bar[XB_TMO])) break; if (sp > XB_SPIN_CAP) { atomicAdd(&bar[XB_TMO], 1u); break; } }
    }
    nloc = mine > 0u ? mine : 1u; nx = cnt > 0u ? cnt : 1u;
}
__device__ __forceinline__ bool xcd_topology_regular(unsigned* bar) {
    bool ok = true;
#pragma unroll
    for (unsigned j = 0; j < 16; ++j) { const unsigned c = xb_ld(&bar[XB_XCNT(j)]); ok = ok && (c == (j < 8u ? 32u : 0u)); }
    return ok;
}
__device__ __forceinline__ void xcd_barrier(const XcdBarrier& b) {
    asm volatile("s_waitcnt vmcnt(0)" ::: "memory");
    __syncthreads();
    if (threadIdx.x == 0) {
        unsigned* bar = b.bar;
        __builtin_amdgcn_s_waitcnt(0);
        unsigned nloc = b.st[0], nx = b.st[1];
        if (nloc == 0u) { xcd_barrier_complete(bar, b.x, nloc, nx); b.st[0] = nloc; b.st[1] = nx; b.st[3] = xcd_topology_regular(bar) ? 1u : 2u; }
        const unsigned old = xb_add(&bar[XB_XSUB(b.x)], 1u);
        const unsigned gen = old / nloc;
        if (old + 1u == (gen + 1u) * nloc) {
            __builtin_amdgcn_fence(__ATOMIC_RELEASE, "agent");
            asm volatile("s_waitcnt vmcnt(0)" ::: "memory");
            const unsigned og = xb_add(&bar[XB_TOP], 1u);
            const unsigned tg = og / nx;
            if (og + 1u == (tg + 1u) * nx) xb_add(&bar[XB_TOPGEN], 1u);
            else XB_SPIN(xb_ld(&bar[XB_TOPGEN]) == tg, bar);
            __builtin_amdgcn_fence(__ATOMIC_ACQUIRE, "agent");
            xb_add(&bar[XB_XGEN(b.x)], 1u);
            asm volatile("s_waitcnt vmcnt(0)" ::: "memory");
        } else {
            XB_SPIN(xb_ld(&bar[XB_XGEN(b.x)]) == gen, bar);
            __builtin_amdgcn_fence(__ATOMIC_ACQUIRE, "agent");
            asm volatile("s_waitcnt vmcnt(0)" ::: "memory");
        }
    }
    __syncthreads();
}

__device__ __forceinline__ void xcd_local_barrier(const XcdBarrier& b, unsigned& lgen, unsigned* extra = nullptr, unsigned extra_target = 0u) {
    asm volatile("s_waitcnt vmcnt(0)" ::: "memory");
    __syncthreads();
    if (threadIdx.x == 0) {
        __builtin_amdgcn_s_waitcnt(0);
        unsigned* w = &b.bar[XB_LOC(b.x)];
        (void)xb_add(w, 1u);
        __builtin_amdgcn_fence(__ATOMIC_ACQUIRE, "agent");
        const unsigned target = (lgen + 1u) * 32u;
        XB_SPIN(xb_ld(w) < target, b.bar);
        if (extra) XB_SPIN(xb_ld(extra) < extra_target, b.bar);
        asm volatile("s_waitcnt vmcnt(0)" ::: "memory");
    }
    ++lgen;
    __syncthreads();
}

__device__ __forceinline__ void xcd_panel_barrier(const XcdBarrier& b, unsigned& pgen, int pm, unsigned* extra = nullptr, unsigned extra_target = 0u) {
    asm volatile("s_waitcnt vmcnt(0)" ::: "memory");
    __syncthreads();
    if (threadIdx.x == 0) {
        __builtin_amdgcn_s_waitcnt(0);
        unsigned* w = &b.bar[XB_PNL(pm)];
        (void)xb_add(w, 1u);
        __builtin_amdgcn_fence(__ATOMIC_ACQUIRE, "agent");
        const unsigned target = (pgen + 1u) * 4u;
        XB_SPIN(xb_ld(w) < target, b.bar);
        if (extra) XB_SPIN(xb_ld(extra) < extra_target, b.bar);
        asm volatile("s_waitcnt vmcnt(0)" ::: "memory");
    }
    ++pgen;
    __syncthreads();
}

struct Frame {
    LAS unsigned char* lds;
    volatile LAS unsigned* MISC;
    gu32* ctl;
    int tid, lane, wave;
    int vcu, G;
};
__device__ __forceinline__ float wave_sum(float v) {
#pragma unroll
    for (int o = 1; o < 64; o <<= 1) v += __shfl_xor(v, o);
    return v;
}

__device__ __forceinline__ int dest_row(int mode, int n0) {
    if (mode == 0) return n0;
    if (mode == 1) return 256 * (n0 >> 7) + (n0 & 127);
    if (mode == 2) return 256 * (n0 >> 7) + 128 + (n0 & 127);
    return 256 * (n0 >> 8) + 128 * ((n0 >> 5) & 1) + 32 * ((n0 >> 6) & 3);
}
template <bool WTH = false>
__device__ __forceinline__ void p0_transpose_item(const float* W, int K, int N, bf16* WT, int mode, const float* gain, LAS float* scr, int item, int lane) {
    const int nblk = N / 32, kb = item / nblk, nb = item % nblk, k0 = 64 * kb, n0 = 32 * nb;
    { f32x4 t[8];
#pragma unroll
      for (int i = 0; i < 8; ++i) t[i] = __builtin_nontemporal_load((const f32x4*)(W + (size_t)(k0 + 8 * i + (lane >> 3)) * N + n0 + 4 * (lane & 7)));
#pragma unroll
      for (int i = 0; i < 8; ++i) { LAS float* d = scr + (8 * i + (lane >> 3)) * 33 + 4 * (lane & 7); d[0] = t[i][0]; d[1] = t[i][1]; d[2] = t[i][2]; d[3] = t[i][3]; } }
    LDS_WAIT(); asm volatile("" ::: "memory");
    const int c = lane & 7;
    f32x4 ga = (f32x4){1.f, 1.f, 1.f, 1.f}, gb = ga;
    if (gain) { ga = *(const f32x4*)(gain + k0 + 8 * c); gb = *(const f32x4*)(gain + k0 + 8 * c + 4); }
    const int r0 = dest_row(mode, n0);
    const __amdgpu_buffer_rsrc_t wtr = WT_RSRC(WT);
#pragma unroll
    for (int j = 0; j < 4; ++j) { const int n = (lane >> 3) + 8 * j; const LAS float* s = scr + (8 * c) * 33 + n;
        v4u o; o.x = pk2(s[0 * 33] * ga[0], s[1 * 33] * ga[1]); o.y = pk2(s[2 * 33] * ga[2], s[3 * 33] * ga[3]); o.z = pk2(s[4 * 33] * gb[0], s[5 * 33] * gb[1]); o.w = pk2(s[6 * 33] * gb[2], s[7 * 33] * gb[3]);
        if (WTH) WT_ST16(wtr, ((size_t)(r0 + n) * K + k0 + 8 * c) * 2, o); else *(GAS v4u*)(WT + (size_t)(r0 + n) * K + k0 + 8 * c) = o; }
    LDS_WAIT(); asm volatile("" ::: "memory");
}

namespace mixp {
__device__ const unsigned char kBucket[128] = {0,1,2,3,4,5,6,7,8,9,10,11,12,13,14,15,16,16,16,17,17,18,18,18,19,19,19,20,20,20,20,21,21,21,21,22,22,22,22,22,23,23,23,23,23,23,24,24,24,24,24,24,25,25,25,25,25,25,25,26,26,26,26,26,26,26,26,27,27,27,27,27,27,27,27,27,27,28,28,28,28,28,28,28,28,28,28,29,29,29,29,29,29,29,29,29,29,29,29,30,30,30,30,30,30,30,30,30,30,30,30,30,30,31,31,31,31,31,31,31,31,31,31,31,31,31,31,31};
constexpr int ZP = FF, YP = FF;
constexpr int L_K = 0, L_V = 32768, L_TB = 65536, L_U = 68608, L_PA = 0;
constexpr float NEG = -1e30f;
typedef short v4i16_t __attribute__((ext_vector_type(4)));
__device__ __forceinline__ s16x4 vtr(const LAS unsigned char* p) { return __builtin_bit_cast(s16x4, __builtin_amdgcn_ds_read_tr16_b64_v4i16((LAS v4i16_t*)p)); }
__device__ __forceinline__ unsigned cvtpk(float lo, float hi) { unsigned r; asm volatile("v_cvt_pk_bf16_f32 %0, %1, %2" : "=v"(r) : "v"(lo), "v"(hi)); return r; }

__device__ __forceinline__ int fsw(int r) { return (((r >> 1) & 1) << 2) | ((r >> 2) & 1) | (((r >> 3) & 1) << 1); }
__device__ __forceinline__ void store16_rows(bf16* rowp  , int h2, v2u g0, v2u g1, v2u g2, v2u g3) {
    { const auto rx = __builtin_amdgcn_permlane32_swap(g0.x, g1.x, false, false); const auto ry = __builtin_amdgcn_permlane32_swap(g0.y, g1.y, false, false);
      *(GAS v4u*)(rowp + 8 * h2) = (v4u){rx[0], ry[0], rx[1], ry[1]}; }
    { const auto rx = __builtin_amdgcn_permlane32_swap(g2.x, g3.x, false, false); const auto ry = __builtin_amdgcn_permlane32_swap(g2.y, g3.y, false, false);
      *(GAS v4u*)(rowp + 16 + 8 * h2) = (v4u){rx[0], ry[0], rx[1], ry[1]}; }
}
struct UTile { v4u x[5]; };
__device__ __forceinline__ void utile_load(UTile& U, const bf16* Z, int pu, int tid) {
    const int tile = pu >> 2, g = pu & 3, t0 = tile * 128, s0 = t0 % SEQ;
#pragma unroll
    for (int k = 0; k < 5; ++k) {
        const int chunk = tid + 512 * k, row = chunk >> 4, c = chunk & 15;
        const bool ok = (k < 4 || tid < 256) && (s0 > 0 || row >= 16);
        const int rr = ok ? row : 16;
        const v4u v = *(const GAS v4u*)(Z + (size_t)(t0 - 16 + rr) * ZP + 768 + g * 128 + 8 * c);
        U.x[k] = ok ? v : (v4u){0u, 0u, 0u, 0u};
    }
}
__device__ __forceinline__ void utile_store(const UTile& U, LAS unsigned char* lds, int tid) {
#pragma unroll
    for (int k = 0; k < 5; ++k) { const int chunk = tid + 512 * k; if (k < 4 || tid < 256) *(LAS v4u*)(lds + L_U + chunk * 16) = U.x[k]; }
}

__device__ __forceinline__ void attn_unit(LAS unsigned char* lds, const bf16* Z, bf16* Y, const float* sinks, const float* rel_bias, int unit, int pu0, int tid, int wid, int lane) {
    const int b = unit >> 5, blk = (unit >> 1) & 15, kv = unit & 1;
    const int tok0 = b * SEQ + blk * 128;
    const int g = wid >> 1, rh = wid & 1, h = kv * 4 + g;
    const int q32 = lane & 31, h2 = lane >> 5;
    v4u kk[4], vv[4];
#pragma unroll
    for (int i = 0; i < 4; ++i) {
        const int chunk = tid + 512 * i, row = chunk >> 3, c = chunk & 7;
        const int rr = (blk > 0 || row >= 128) ? row : 128;
        const bf16* src = Z + (size_t)(tok0 - 128 + rr) * ZP + 512 + kv * 64 + c * 8;
        kk[i] = *(const GAS v4u*)(src); vv[i] = *(const GAS v4u*)(src + 128);
    }
    bf16x8 qf[2][4];
#pragma unroll
    for (int jj = 0; jj < 2; ++jj) { const bf16* qp = Z + (size_t)(tok0 + 32 * (2 * rh + jj) + q32) * ZP + h * 64 + 8 * h2;
#pragma unroll
        for (int s = 0; s < 4; ++s) qf[jj][s] = *(const GAS bf16x8*)(qp + 16 * s); }
    UTile U; if (pu0 >= 0) utile_load(U, Z, pu0, tid);
    for (int i = tid; i < 768; i += 512) { const int gg = i / 192, dd = i % 192 - 32; const int dc = dd < 0 ? 0 : (dd > 127 ? 127 : dd); ((LAS float*)(lds + L_TB))[i] = (rel_bias[kBucket[dc] * 8 + kv * 4 + gg] - sinks[kv * 4 + gg]) * LOG2E; }
#pragma unroll
    for (int i = 0; i < 4; ++i) { const int chunk = tid + 512 * i, row = chunk >> 3, c = chunk & 7;
        const int sl = (c ^ fsw(row)) * 16; *(LAS v4u*)(lds + L_K + row * 128 + sl) = kk[i]; *(LAS v4u*)(lds + L_V + row * 128 + sl) = vv[i]; }
    if (pu0 >= 0) utile_store(U, lds, tid);
    LDS_WAIT(); __syncthreads();
    const LAS float* tb = (const LAS float*)(lds + L_TB) + g * 192 + 32 + q32 - 4 * h2;
    int koff[4];
#pragma unroll
    for (int sx = 0; sx < 4; ++sx) koff[sx] = q32 * 128 + (((2 * sx + h2) ^ fsw(q32)) * 16);
    int voff[2][2];
#pragma unroll
    for (int a = 0; a < 2; ++a)
#pragma unroll
        for (int dh = 0; dh < 2; ++dh) { const int vr = 8 * a + 4 * (lane >> 5) + ((lane & 15) >> 2), ch = 4 * dh + 2 * ((lane >> 4) & 1) + ((lane & 3) >> 1);
            voff[a][dh] = vr * 128 + ((ch ^ fsw(vr)) * 16) + 8 * (lane & 1); }
#pragma unroll
    for (int jj = 0; jj < 2; ++jj) {
        const int j = 2 * rh + jj;
        f32x16 S[5];
#pragma unroll
        for (int t = 0; t < 5; ++t) {
            const int kt = j + t;
            if (blk == 0 && kt < 4) {
#pragma unroll
                for (int r = 0; r < 16; ++r) S[t][r] = NEG;
            } else {
                f32x16 a = {};
#pragma unroll
                for (int s = 0; s < 4; ++s) { const bf16x8 kf = *(const LAS bf16x8*)(lds + L_K + 32 * kt * 128 + koff[s]); a = __builtin_amdgcn_mfma_f32_32x32x16_bf16(kf, qf[jj][s], a, 0, 0, 0); }
#pragma unroll
                for (int r = 0; r < 16; ++r) {
                    const int cofs = 128 - 32 * t - ((r & 3) + 8 * (r >> 2));
                    const float v = a[r] + tb[cofs];
                    if (t == 0) a[r] = (cofs + q32 - 4 * h2 <= 127) ? v : NEG;
                    else if (t == 4) a[r] = (cofs + q32 - 4 * h2 >= 0) ? v : NEG;
                    else a[r] = v;
                }
                S[t] = a;
            }
        }
        float lsum = 0.f;
#pragma unroll
        for (int t = 0; t < 5; ++t)
#pragma unroll
            for (int r = 0; r < 16; ++r) { const float p = __builtin_amdgcn_exp2f(S[t][r]); S[t][r] = p; lsum += p; }
        lsum += __shfl_xor(lsum, 32);
        lsum += 1.0f;
        f32x16 o0 = {}, o1 = {};
#pragma unroll
        for (int t = 0; t < 5; ++t) {
            const int kt = j + t;
            if (!(blk == 0 && kt < 4)) {
#pragma unroll
                for (int s = 0; s < 2; ++s) {
                    v4u pw; pw.x = cvtpk(S[t][8 * s + 0], S[t][8 * s + 1]); pw.y = cvtpk(S[t][8 * s + 2], S[t][8 * s + 3]); pw.z = cvtpk(S[t][8 * s + 4], S[t][8 * s + 5]); pw.w = cvtpk(S[t][8 * s + 6], S[t][8 * s + 7]);
                    const bf16x8 pf = __builtin_bit_cast(bf16x8, pw);
                    const LAS unsigned char* vb = lds + L_V + (32 * kt + 16 * s) * 128;
                    const s16x4 a0 = vtr(vb + voff[0][0]), a1 = vtr(vb + voff[1][0]), b0 = vtr(vb + voff[0][1]), b1 = vtr(vb + voff[1][1]);
                    const bf16x8 v0 = (bf16x8){a0[0], a0[1], a0[2], a0[3], a1[0], a1[1], a1[2], a1[3]};
                    const bf16x8 v1 = (bf16x8){b0[0], b0[1], b0[2], b0[3], b1[0], b1[1], b1[2], b1[3]};
                    o0 = __builtin_amdgcn_mfma_f32_32x32x16_bf16(v0, pf, o0, 0, 0, 0);
                    o1 = __builtin_amdgcn_mfma_f32_32x32x16_bf16(v1, pf, o1, 0, 0, 0);
                }
            }
        }
        const float rl = 1.0f / lsum;
        bf16* yp = Y + (size_t)(tok0 + 32 * j + q32) * YP + h * 64;
        v2u w0[4], w1[4];
#pragma unroll
        for (int rg = 0; rg < 4; ++rg) {
            w0[rg].x = cvtpk(o0[4 * rg + 0] * rl, o0[4 * rg + 1] * rl); w0[rg].y = cvtpk(o0[4 * rg + 2] * rl, o0[4 * rg + 3] * rl);
            w1[rg].x = cvtpk(o1[4 * rg + 0] * rl, o1[4 * rg + 1] * rl); w1[rg].y = cvtpk(o1[4 * rg + 2] * rl, o1[4 * rg + 3] * rl);
        }
        store16_rows(yp, h2, w0[0], w0[1], w0[2], w0[3]); store16_rows(yp + 32, h2, w1[0], w1[1], w1[2], w1[3]);
    }
    LDS_WAIT(); __syncthreads();
}

__device__ __forceinline__ void pool_stage(LAS unsigned char* lds, const bf16* Z, int pu, int tid) { UTile U; utile_load(U, Z, pu, tid); utile_store(U, lds, tid); LDS_WAIT(); __syncthreads(); }
__device__ __forceinline__ void pool_unit(LAS unsigned char* lds, const bf16* Z, bf16* Y, const bf16* WpT, const float* pscale, int pu, int pu_next, int tid, int wid, int lane) {
    const int tile = pu >> 2, g = pu & 3, t0 = tile * 128, s0 = t0 % SEQ, w = 2 << g;
    const int wr4 = wid >> 1, wcn = wid & 1, q32 = lane & 31, h2 = lane >> 5;
    bf16x8 wf[2][8];
    { const bf16* wp = WpT + (size_t)g * 128 * 128 + (size_t)(64 * wcn + q32) * 128 + 8 * h2;
#pragma unroll
      for (int s = 0; s < 8; ++s) { wf[0][s] = *(const GAS bf16x8*)(wp + 16 * s); wf[1][s] = *(const GAS bf16x8*)(wp + 32 * 128 + 16 * s); } }
    {
        const int cv = tid & 15, seg = tid >> 4;
        const LAS unsigned char* ub = lds + L_U + (16 + 4 * seg) * 256 + cv * 16;
        float sum[8];
#pragma unroll
        for (int e = 0; e < 8; ++e) sum[e] = 0.f;
        for (int jx = 0; jx < w; ++jx) {
            const v4u x = *(const LAS v4u*)(ub - jx * 256);
#pragma unroll
            for (int e = 0; e < 4; ++e) { sum[2 * e] += bf2f((unsigned short)(x[e] & 0xffffu)); sum[2 * e + 1] += bf2f((unsigned short)(x[e] >> 16)); }
        }
#pragma unroll
        for (int i = 0; i < 4; ++i) {
            const int tt = 4 * seg + i;
            const v4u xc = *(const LAS v4u*)(ub + i * 256);
            float cur[8];
#pragma unroll
            for (int e = 0; e < 4; ++e) { cur[2 * e] = bf2f((unsigned short)(xc[e] & 0xffffu)); cur[2 * e + 1] = bf2f((unsigned short)(xc[e] >> 16)); }
            if (i > 0) {
                const v4u xo = *(const LAS v4u*)(ub + (i - w) * 256);
#pragma unroll
                for (int e = 0; e < 4; ++e) { sum[2 * e] += cur[2 * e] - bf2f((unsigned short)(xo[e] & 0xffffu)); sum[2 * e + 1] += cur[2 * e + 1] - bf2f((unsigned short)(xo[e] >> 16)); }
            }
            const int cn = (s0 + tt + 1) < w ? (s0 + tt + 1) : w; const float ic = 1.0f / (float)cn;
            v4u o;
            o.x = cvtpk(sum[0] * ic - cur[0], sum[1] * ic - cur[1]); o.y = cvtpk(sum[2] * ic - cur[2], sum[3] * ic - cur[3]);
            o.z = cvtpk(sum[4] * ic - cur[4], sum[5] * ic - cur[5]); o.w = cvtpk(sum[6] * ic - cur[6], sum[7] * ic - cur[7]);
            *(LAS v4u*)(lds + L_PA + tt * 256 + ((cv ^ (tt & 15)) * 16)) = o;
        }
    }
    LDS_WAIT(); __syncthreads();
    UTile U; if (pu_next >= 0) utile_load(U, Z, pu_next, tid);
    {
        f32x16 acc0 = {}, acc1 = {};
        const int prow = 32 * wr4 + q32;
#pragma unroll
        for (int s = 0; s < 8; ++s) {
            const bf16x8 pf = *(const LAS bf16x8*)(lds + L_PA + prow * 256 + (((2 * s + h2) ^ (prow & 15)) * 16));
            acc0 = __builtin_amdgcn_mfma_f32_32x32x16_bf16(wf[0][s], pf, acc0, 0, 0, 0);
            acc1 = __builtin_amdgcn_mfma_f32_32x32x16_bf16(wf[1][s], pf, acc1, 0, 0, 0);
        }
        bf16* yp = Y + (size_t)(t0 + prow) * YP + 512 + g * 128 + 64 * wcn;
        const float* sp = pscale + g * 128 + 64 * wcn + 4 * h2;
        v2u a[4], c[4];
#pragma unroll
        for (int rg = 0; rg < 4; ++rg) {
            const f32x4 s0v = *(const f32x4*)(sp + 8 * rg), s1v = *(const f32x4*)(sp + 32 + 8 * rg);
            a[rg].x = cvtpk(acc0[4 * rg + 0] * s0v[0], acc0[4 * rg + 1] * s0v[1]); a[rg].y = cvtpk(acc0[4 * rg + 2] * s0v[2], acc0[4 * rg + 3] * s0v[3]);
            c[rg].x = cvtpk(acc1[4 * rg + 0] * s1v[0], acc1[4 * rg + 1] * s1v[1]); c[rg].y = cvtpk(acc1[4 * rg + 2] * s1v[2], acc1[4 * rg + 3] * s1v[3]);
        }
        store16_rows(yp, h2, a[0], a[1], a[2], a[3]); store16_rows(yp + 32, h2, c[0], c[1], c[2], c[3]);
    }
    if (pu_next >= 0) utile_store(U, lds, tid);
    LDS_WAIT(); __syncthreads();
}
}

struct Args { const float* in[18]; float* out; unsigned char* ws; int ph_lo, ph_hi, li, pad; };
__global__ void __launch_bounds__(NWAVES * 64, 2) mega_fwd(Args args) {
    extern __shared__ __attribute__((aligned(16))) unsigned char lds[];
    Frame F;
    F.lds = (LAS unsigned char*)lds;
    F.MISC = (volatile LAS unsigned*)(F.lds + MISC_OFF);
    F.tid = threadIdx.x; F.lane = F.tid & 63; F.wave = __builtin_amdgcn_readfirstlane(F.tid >> 6);
    F.G = gridDim.x; { const int bx = blockIdx.x; F.vcu = (F.G % 8 == 0) ? (bx % 8) * (F.G / 8) + bx / 8 : bx; }
    unsigned char* ws = args.ws;
    F.ctl = (gu32*)(ws + WS_CTL);
    const float* x = args.in[0];
    const float *ffn1_norm = args.in[1], *ffn1_wg = args.in[2], *ffn1_wu = args.in[3], *ffn1_wd = args.in[4], *mix_norm = args.in[5], *w_in = args.in[6], *q_norm = args.in[7], *k_norm = args.in[8];
    const float *sinks = args.in[9], *rel_bias = args.in[10], *pool_w = args.in[11], *pool_scale = args.in[12], *w_out = args.in[13], *ffn2_norm = args.in[14], *ffn2_wg = args.in[15], *ffn2_wu = args.in[16], *ffn2_wd = args.in[17];
    float* out = args.out;
    bf16 *W1GU = (bf16*)(ws + WS_W1GU), *W1D = (bf16*)(ws + WS_W1D), *WIN = (bf16*)(ws + WS_WIN), *WOUT = (bf16*)(ws + WS_WOUT), *W2GU = (bf16*)(ws + WS_W2GU), *W2D = (bf16*)(ws + WS_W2D), *WPOOL = (bf16*)(ws + WS_WPOOL);
    float *SS0 = (float*)(ws + WS_SS0), *SS1 = (float*)(ws + WS_SS1), *SS2 = (float*)(ws + WS_SS2);
    bf16 *XB = (bf16*)(ws + WS_XB), *HB = (bf16*)(ws + WS_H), *YB = (bf16*)(ws + WS_H), *ZB = (bf16*)(ws + WS_H) + D;

    for (int u = F.tid; u < (LDS_BYTES - LDSCTL_OFF) / 4; u += NWAVES * 64) ((LAS unsigned*)(F.lds + LDSCTL_OFF))[u] = 0u;
    __syncthreads();
    const int bli = (N_LAUNCHES == PER_PHASE) ? 0 : args.li;
    XcdBarrier bar; bar.bar = (unsigned*)(F.ctl + CW_BAR) + bli * XCD_BAR_WORDS; bar.x = 0; bar.st = nullptr;
    if (N_LAUNCHES != PER_PHASE) bar = xcd_barrier_post((unsigned*)(F.ctl + CW_BAR) + bli * XCD_BAR_WORDS, F.MISC + 8);
#define GRID_BAR() do { if (N_LAUNCHES != PER_PHASE) xcd_barrier(bar); } while (0)
    unsigned lgen = 0u; bool topo = false; int cid = (int)blockIdx.x;
    unsigned pgen = 0u;
#define LOCAL_BAR() do { if (topo) xcd_local_barrier(bar, lgen); else xcd_barrier(bar); } while (0)
#define PANEL_BAR() do { if (topo) xcd_panel_barrier(bar, pgen, 8 * (cid & 7) + ((cid >> 3) & 7)); else xcd_barrier(bar); } while (0)
    const int lo = args.ph_lo, hi = args.ph_hi;
#define IN(k) (lo <= (k) && (k) < hi)
#define BOTH(k) (IN(k) && IN((k) + 1))

    if (IN(0)) { for (int rep_ = 0; rep_ < NREP(0); ++rep_) {
        LAS float* scr = (LAS float*)(F.lds + RING_OFF + F.wave * 16384);
        const int gw = F.vcu * NWAVES + F.wave, NGW = F.G * NWAVES;
        constexpr int I_GU = (D / 64) * (FF / 32);
        for (int it = gw; it < 2 * I_GU; it += NGW) {
            if (it < I_GU) p0_transpose_item<true>(ffn1_wg, D, FF, W1GU, 1, ffn1_norm, scr, it, F.lane);
            else p0_transpose_item<true>(ffn1_wu, D, FF, W1GU, 2, ffn1_norm, scr, it - I_GU, F.lane);
        }
        LDS_WAIT(); asm volatile("s_waitcnt vmcnt(0)" ::: "memory"); __syncthreads();
        if (F.tid == 0) {
            unsigned nloc = bar.st[0], nx = bar.st[1];
            if (nloc == 0u) { xcd_barrier_complete(bar.bar, bar.x, nloc, nx); bar.st[0] = nloc; bar.st[1] = nx; bar.st[3] = xcd_topology_regular(bar.bar) ? 1u : 2u; }
            (void)xb_add(&bar.bar[XB_W1], 1u);
        }
        __syncthreads();
        topo = (F.MISC[11] == 1u) && F.G == 256;
        if (topo) cid = (int)(F.MISC[10] * 8u + bar.x);
        { const int pm_ = 8 * (cid & 7) + ((cid >> 3) & 7), jw = (cid >> 6) * NWAVES + F.wave;
          for (int i = 0; i < 8; ++i) {
            const int m = topo ? pm_ * 256 + jw + 32 * i : gw + i * NGW;
            const GAS f32x4* xr = (const GAS f32x4*)(x + (size_t)m * D) + F.lane;
            f32x4 v[4]; float s = 0.f;
#pragma unroll
            for (int j = 0; j < 4; ++j) { v[j] = __builtin_nontemporal_load(xr + 64 * j); s += (v[j].x * v[j].x + v[j].y * v[j].y) + (v[j].z * v[j].z + v[j].w * v[j].w); }
            s = wave_sum(s);
            GAS unsigned long long* o8 = (GAS unsigned long long*)(XB + (size_t)m * D) + F.lane;
#pragma unroll
            for (int j = 0; j < 4; ++j) o8[64 * j] = (unsigned long long)pk2(v[j].x, v[j].y) | ((unsigned long long)pk2(v[j].z, v[j].w) << 32);
            if (F.lane < 4) SS0[(size_t)m * 4 + F.lane] = F.lane == 0 ? s : 0.f;
          } }
        }
        if (BOTH(0)) { if (topo) xcd_panel_barrier(bar, pgen, 8 * (cid & 7) + ((cid >> 3) & 7), &bar.bar[XB_W1], (unsigned)F.G); else xcd_barrier(bar); }
    }
    if (IN(1)) {
        if (cid >= ((M / 256) * (NGU / 256)) % F.G) {
            const int nlo = ((M / 256) * (NGU / 256)) % F.G, ncv = F.G - nlo;
            LAS float* scr = (LAS float*)(F.lds + RING_OFF + F.wave * 16384);
            const int gw = (cid - nlo) * NWAVES + F.wave, NGW = ncv * NWAVES;
            constexpr int I_GU = (D / 64) * (FF / 32), I_DN = (FF / 64) * (D / 32), I_IN = (D / 64) * (DIN / 32), I_OUT = (D / 64) * (D / 32), I_PL = (128 / 64) * (128 / 32);
            constexpr int NITEMS = 2 * I_GU + 2 * I_DN + I_IN + I_OUT + 4 * I_PL;
            for (int it = gw; it < NITEMS; it += NGW) {
                int r = it;
                if (r < I_DN) { p0_transpose_item<true>(ffn1_wd, FF, D, W1D, 0, nullptr, scr, r, F.lane); continue; } r -= I_DN;
                if (r < I_IN) { p0_transpose_item<true>(w_in, D, DIN, WIN, 3, mix_norm, scr, r, F.lane); continue; } r -= I_IN;
                if (r < I_OUT) { p0_transpose_item<true>(w_out, D, D, WOUT, 0, nullptr, scr, r, F.lane); continue; } r -= I_OUT;
                if (r < 4 * I_PL) { const int gp = r / I_PL; p0_transpose_item<true>(pool_w + (size_t)gp * 128 * 128, 128, 128, WPOOL + (size_t)gp * 128 * 128, 0, nullptr, scr, r % I_PL, F.lane); continue; } r -= 4 * I_PL;
                if (r < I_GU) { p0_transpose_item<true>(ffn2_wg, D, FF, W2GU, 1, ffn2_norm, scr, r, F.lane); continue; } r -= I_GU;
                if (r < I_GU) { p0_transpose_item<true>(ffn2_wu, D, FF, W2GU, 2, ffn2_norm, scr, r, F.lane); continue; } r -= I_GU;
                p0_transpose_item<true>(ffn2_wd, FF, D, W2D, 0, nullptr, scr, r, F.lane);
            }
            LDS_WAIT(); asm volatile("s_waitcnt vmcnt(0)" ::: "memory");
            __syncthreads();
            if (F.tid == 0) (void)xb_add(&bar.bar[XB_CONV], 1u);
        }
        pg8::Gemm g{XB, W1GU, M, NGU, D}; pg8::StaticOrder S; S.init(M, NGU, F.G, cid);
        pg8::EpiSwiGLU E{HB, FF, SS0};
        for (int rep_ = 0; rep_ < NREP(1); ++rep_) pg8::gemm_phase<pg8::EpiSwiGLU, pg8::StaticOrder, PG8_ALIGN, PG8_SP2>(F.lds + RING_OFF, g, S, E);
        if (BOTH(1)) { if (topo) xcd_panel_barrier(bar, pgen, 8 * (cid & 7) + ((cid >> 3) & 7), &bar.bar[XB_CONV], (unsigned)(F.G - ((M / 256) * (NGU / 256)) % F.G)); else xcd_barrier(bar); }
    }
    if (IN(2)) {
        pg8::Gemm g{HB, W1D, M, D, FF}; g.rev = true; pg8::StaticOrder S; S.init(M, D, F.G, cid);
        pg8::EpiResid<true, true> E{nullptr, XB, nullptr, XB, SS1, 0.5f};
        pg8::gemm_phase<pg8::EpiResid<true, true>, pg8::StaticOrder, PG8_ALIGN, PG8_SP2>(F.lds + RING_OFF, g, S, E);
        if (BOTH(2)) PANEL_BAR();
    }
    if (IN(3)) {
        pg8::Gemm g{XB, WIN, M, DIN, D}; pg8::StaticOrder S; S.init(M, DIN, F.G, cid); S.r1 = 1;
        pg8::EpiZ E{ZB, FF, SS1, q_norm, k_norm, QSCALE};
        pg8::gemm_phase<pg8::EpiZ, pg8::StaticOrder, PG8_ALIGN, PG8_SP2>(F.lds + RING_OFF, g, S, E);
        if (BOTH(3)) LOCAL_BAR();
    }
    if (IN(4)) {
        const int xb_ = cid & 7, rk = cid >> 3;
        if (rk < 8) {
            pg8::Gemm g{XB, WIN, M, DIN, D}; pg8::StaticOrder S; S.init(M, DIN, F.G, cid); S.r0 = 1; S.r1 = 2;
            pg8::EpiZ E{ZB, FF, SS1, q_norm, k_norm, QSCALE};
            pg8::gemm_phase<pg8::EpiZ, pg8::StaticOrder, PG8_ALIGN, PG8_SP2>(F.lds + RING_OFF, g, S, E);
        } else if (rk < 16) {
            const int a = rk - 8;
            mixp::attn_unit(F.lds + RING_OFF, ZB, YB, sinks, rel_bias, 32 * xb_ + 2 * a, -1, F.tid, F.wave, F.lane);
            mixp::attn_unit(F.lds + RING_OFF, ZB, YB, sinks, rel_bias, 32 * xb_ + 2 * a + 1, -1, F.tid, F.wave, F.lane);
        } else {
            const int p = rk - 16, pu0 = 4 * (16 * xb_ + p), pu1 = pu0 + 1;
            mixp::attn_unit(F.lds + RING_OFF, ZB, YB, sinks, rel_bias, 32 * xb_ + 16 + p, pu0, F.tid, F.wave, F.lane);
            mixp::pool_unit(F.lds + RING_OFF, ZB, YB, WPOOL, pool_scale, pu0, pu1, F.tid, F.wave, F.lane);
            mixp::pool_unit(F.lds + RING_OFF, ZB, YB, WPOOL, pool_scale, pu1, -1, F.tid, F.wave, F.lane);
        }
        if (BOTH(4)) LOCAL_BAR();
    }
    if (IN(5)) {
        pg8::Gemm g{YB, WOUT, M, D, D, FF}; pg8::StaticOrder S; S.init(M, D, F.G, cid);
        { pg8::Unit u0; S.next(0, u0);
          const int pu = 4 * (2 * u0.pm + (u0.pn >> 1)) + 2 + (u0.pn & 1);
          mixp::pool_stage(F.lds + RING_OFF, ZB, pu, F.tid);
          mixp::pool_unit(F.lds + RING_OFF, ZB, YB, WPOOL, pool_scale, pu, -1, F.tid, F.wave, F.lane);
          PANEL_BAR(); }
        pg8::EpiResid<true, true> E{nullptr, XB, nullptr, XB, SS2, 1.0f};
        pg8::gemm_phase<pg8::EpiResid<true, true>, pg8::StaticOrder, PG8_ALIGN, PG8_SP2>(F.lds + RING_OFF, g, S, E);
        if (BOTH(5)) LOCAL_BAR();
    }
    if (IN(6)) {
        pg8::Gemm g{XB, W2GU, M, NGU, D}; pg8::StaticOrder S; S.init(M, NGU, F.G, cid);
        pg8::EpiSwiGLU E{HB, FF, SS2};
        for (int rep_ = 0; rep_ < NREP(6); ++rep_) pg8::gemm_phase<pg8::EpiSwiGLU, pg8::StaticOrder, PG8_ALIGN, PG8_SP2>(F.lds + RING_OFF, g, S, E);
        if (BOTH(6)) PANEL_BAR();
    }
    if (IN(7)) {
        pg8::Gemm g{HB, W2D, M, D, FF}; g.rev = true; pg8::StaticOrder S; S.init(M, D, F.G, cid);
        pg8::EpiResid<true, false> E{nullptr, XB, out, nullptr, nullptr, 0.5f};
        for (int rep_ = 0; rep_ < NREP(7); ++rep_) pg8::gemm_phase<pg8::EpiResid<true, false>, pg8::StaticOrder, PG8_ALIGN, PG8_SP2>(F.lds + RING_OFF, g, S, E);
    }
#undef IN
#undef BOTH
#undef GRID_BAR
}

extern "C" void kernel_launch(void* const* d_in, const int* in_sizes, int n_in, void* d_out, int out_size, void* d_ws, size_t ws_size, hipStream_t stream) {
    static int grid = 0;
    if (grid == 0) {
        if (n_in != 18 || in_sizes[0] != M * D || out_size != M * D || ws_size < WS_END) { fprintf(stderr, "kernel_launch: unexpected shapes (n_in %d, in0 %d, out %d, ws %zu); nothing launched\n", n_in, n_in > 0 ? in_sizes[0] : -1, out_size, ws_size); grid = -1; return; }
        int dev = 0, cus = 0, per_cu = 0;
        if (hipGetDevice(&dev) != hipSuccess || hipDeviceGetAttribute(&cus, hipDeviceAttributeMultiprocessorCount, dev) != hipSuccess) { grid = -1; return; }
        if (hipFuncSetAttribute((const void*)mega_fwd, hipFuncAttributeMaxDynamicSharedMemorySize, LDS_BYTES) != hipSuccess) { fprintf(stderr, "kernel_launch: hipFuncSetAttribute failed\n"); grid = -1; return; }
        if (hipOccupancyMaxActiveBlocksPerMultiprocessor(&per_cu, (const void*)mega_fwd, NWAVES * 64, LDS_BYTES) != hipSuccess || per_cu < 1)
            fprintf(stderr, "kernel_launch: note: occupancy query reports %d workgroups per CU\n", per_cu);
        (void)hipGetLastError();
        grid = cus;
        if (grid != 256) fprintf(stderr, "kernel_launch: note: %d CUs (tuned for 256)\n", grid);
    }
    if (grid < 0) return;
    if (hipMemsetAsync((char*)d_ws + WS_CTL, 0, CTL_ZERO_BYTES, stream) != hipSuccess) { fprintf(stderr, "kernel_launch: hipMemsetAsync failed\n"); return; }
    Args a{};
    for (int i = 0; i < 18; ++i) a.in[i] = (const float*)d_in[i];
    a.out = (float*)d_out; a.ws = (unsigned char*)d_ws;
    for (int li = 0; li < N_LAUNCHES; ++li) {
        if (N_LAUNCHES == PER_PHASE) { a.ph_lo = li; a.ph_hi = li + 1; } else { a.ph_lo = 0; a.ph_hi = PER_PHASE; }
        a.li = li;
        hipLaunchKernelGGL(mega_fwd, dim3(grid), dim3(NWAVES * 64), LDS_BYTES, stream, a);
        const hipError_t le = hipPeekAtLastError();
        if (le != hipSuccess) { fprintf(stderr, "kernel_launch: launch %d failed: %s\n", li, hipGetErrorName(le)); break; }
    }
}
```
